# Optimizing an MI355X kernel written in HIP

```python
import jax, jax.numpy as jnp
from jax import lax
import numpy as np

D_MODEL = 2048
BATCH = 4
SEQ = 2048
DEPTH = 4

PLE_DIM = 256
ROPE_THETA = 10000.0
NORM_EPS = 1e-6
Q_BLOCK = 128
NEG = -1e30
FORCE = 1e6

GLA_HEADS = 8
GLA_DK = 64
GLA_DV = 128
GLA_GATE_RANK = 16
GLA_TAU = 16.0
GLA_CHUNK = 64

MLA_HEADS = 8
MLA_Q_RANK = 512
MLA_KV_RANK = 512
MLA_NOPE = 128
MLA_ROPE = 64
MLA_V = 128

NSA_HEADS = 16
NSA_KV_GROUPS = 4
NSA_HPG = NSA_HEADS // NSA_KV_GROUPS
NSA_HEAD_DIM = 128
NSA_CMP_LEN = 32
NSA_CMP_STRIDE = 16
NSA_SEL_LEN = 64
NSA_SEL_TOPK = 16
NSA_WINDOW = 512
NSA_SEL_QCHUNK = 32

FFN_HIDDEN = -(-8 * D_MODEL // (3 * 256)) * 256

AB_SPLITS = (GLA_HEADS * GLA_DK, GLA_HEADS * GLA_DK, GLA_HEADS * GLA_DV, GLA_HEADS * GLA_DV,
             GLA_GATE_RANK, MLA_Q_RANK, MLA_KV_RANK, MLA_ROPE)
AB_IN = sum(AB_SPLITS)
AB_MIX = GLA_HEADS * GLA_DV + MLA_HEADS * MLA_V
NSA_KV_W = NSA_KV_GROUPS * NSA_HEAD_DIM
NSA_SPLITS = (NSA_HEADS * NSA_HEAD_DIM,) + (NSA_KV_W,) * 6 + (3 * NSA_HEADS,)
NSA_IN = sum(NSA_SPLITS)
NSA_MIX = NSA_HEADS * NSA_HEAD_DIM

kernel_name = "hybrid_gla_mla_nsa_sandwich_ple"


def split_cols(z, widths):
    out, off = [], 0
    for w in widths:
        out.append(z[..., off:off + w])
        off += w
    return out


def rms_norm(x, w):
    xf = x.astype(jnp.float32)
    y = xf * lax.rsqrt(jnp.mean(xf * xf, axis=-1, keepdims=True) + NORM_EPS)
    return (y * w.astype(jnp.float32)).astype(x.dtype)


def rope_tables(positions, dim):
    inv = jnp.power(ROPE_THETA, -jnp.arange(0, dim, 2, dtype=jnp.float32) / dim)
    ang = positions.astype(jnp.float32)[..., None] * inv
    return jnp.cos(ang), jnp.sin(ang)


def apply_rope(x, cos, sin):
    half = x.shape[-1] // 2
    xf = x.astype(jnp.float32)
    x1, x2 = xf[..., :half], xf[..., half:]
    return jnp.concatenate([x1 * cos - x2 * sin, x2 * cos + x1 * sin], axis=-1).astype(x.dtype)


def gla_chunked(q, k, v, log_a):
    B, H, S, dk = q.shape
    dv = v.shape[-1]
    L = GLA_CHUNK
    N = S // L
    f32 = jnp.float32
    qf = q.astype(f32).reshape(B, H, N, L, dk) * (dk ** -0.5)
    kf = k.astype(f32).reshape(B, H, N, L, dk)
    vf = v.astype(f32).reshape(B, H, N, L, dv)
    b = jnp.cumsum(log_a.astype(f32).reshape(B, H, N, L, dk), axis=3)
    b_end = b[:, :, :, -1:, :]
    q_dec = qf * jnp.exp(b)
    k_inv = kf * jnp.exp(-b)
    k_end = kf * jnp.exp(b_end - b)
    causal = jnp.tril(jnp.ones((L, L), dtype=bool))
    attn = jnp.where(causal, jnp.einsum('bhnid,bhnjd->bhnij', q_dec, k_inv), 0.0)
    o_intra = jnp.einsum('bhnij,bhnjv->bhniv', attn, vf)
    upd = jnp.einsum('bhnjd,bhnjv->bhndv', k_end, vf)
    decay = jnp.exp(b_end[:, :, :, 0, :])

    def step(state, inp):
        dec, u = inp
        return dec[..., None] * state + u, state

    s0 = jnp.zeros((B, H, dk, dv), f32)
    _, s_prev = lax.scan(step, s0, (jnp.moveaxis(decay, 2, 0), jnp.moveaxis(upd, 2, 0)))
    s_prev = jnp.moveaxis(s_prev, 0, 2)
    o_inter = jnp.einsum('bhnid,bhndv->bhniv', q_dec, s_prev)
    return (o_intra + o_inter).reshape(B, H, S, dv).astype(v.dtype)


def causal_attention_blocks(q, k, v, scale):
    B, H, S, dq = q.shape
    nb = S // Q_BLOCK
    q_b = jnp.moveaxis(q.reshape(B, H, nb, Q_BLOCK, dq), 2, 0)
    kpos = jnp.arange(S)

    def one(args):
        qb, i = args
        s = jnp.einsum('bhqd,bhkd->bhqk', qb, k).astype(jnp.float32) * scale
        qpos = i * Q_BLOCK + jnp.arange(Q_BLOCK)
        s = jnp.where(kpos[None, :] <= qpos[:, None], s, NEG)
        p = jax.nn.softmax(s, axis=-1)
        return jnp.einsum('bhqk,bhkd->bhqd', p.astype(v.dtype), v)

    o = lax.map(one, (q_b, jnp.arange(nb)))
    return jnp.moveaxis(o, 0, 2).reshape(B, H, S, v.shape[-1])


def gla_mla_mixer(h, cos64, sin64, w_in, w_alpha_up, b_alpha, gla_norm_w,
                  q_norm_w, w_uq, kv_norm_w, w_ukv, w_out):
    B, S, _ = h.shape
    z = h @ w_in
    q_g, k_g, v_g, g_g, a_lr, c_q, c_kv, k_r = split_cols(z, AB_SPLITS)

    def heads(t, n):
        return t.reshape(B, S, n, -1).transpose(0, 2, 1, 3)

    log_a = jax.nn.log_sigmoid((a_lr @ w_alpha_up + b_alpha).astype(jnp.float32)) / GLA_TAU
    o_gla = gla_chunked(heads(q_g, GLA_HEADS), heads(k_g, GLA_HEADS), heads(v_g, GLA_HEADS),
                        heads(log_a, GLA_HEADS))
    o_gla = rms_norm(o_gla.transpose(0, 2, 1, 3), gla_norm_w).reshape(B, S, -1) * jax.nn.silu(g_g)

    q = (rms_norm(c_q, q_norm_w) @ w_uq).reshape(B, S, MLA_HEADS, MLA_NOPE + MLA_ROPE).transpose(0, 2, 1, 3)
    kv = (rms_norm(c_kv, kv_norm_w) @ w_ukv).reshape(B, S, MLA_HEADS, MLA_NOPE + MLA_V).transpose(0, 2, 1, 3)
    q_rope = apply_rope(q[..., MLA_NOPE:], cos64[:, None], sin64[:, None])
    k_rope = apply_rope(k_r, cos64, sin64)[:, None]
    qm = jnp.concatenate([q[..., :MLA_NOPE], q_rope], axis=-1)
    km = jnp.concatenate([kv[..., :MLA_NOPE],
                          jnp.broadcast_to(k_rope, (B, MLA_HEADS, S, MLA_ROPE))], axis=-1)
    o_mla = causal_attention_blocks(qm, km, kv[..., MLA_NOPE:], (MLA_NOPE + MLA_ROPE) ** -0.5)
    o_mla = o_mla.transpose(0, 2, 1, 3).reshape(B, S, -1)
    return jnp.concatenate([o_gla, o_mla.astype(o_gla.dtype)], axis=-1) @ w_out


def nsa_compress(t, pos, w1, w2):
    S = t.shape[2]
    nc = (S - NSA_CMP_LEN) // NSA_CMP_STRIDE + 1
    idx = jnp.arange(nc)[:, None] * NSA_CMP_STRIDE + jnp.arange(NSA_CMP_LEN)[None, :]
    blocks = t[:, :, idx, :] + pos
    flat = blocks.reshape(blocks.shape[0], blocks.shape[1], nc, NSA_CMP_LEN * t.shape[-1])
    return jax.nn.gelu(flat @ w1) @ w2


def nsa_compressed_branch(q, kc, vc, cmp_pos, cmp_w1, cmp_w2, scale):
    S = q.shape[3]
    k_cmp = nsa_compress(kc, cmp_pos[0], cmp_w1[0], cmp_w2[0])
    v_cmp = nsa_compress(vc, cmp_pos[1], cmp_w1[1], cmp_w2[1])
    nc = k_cmp.shape[2]
    s = jnp.einsum('bgjsd,bgnd->bgjsn', q, k_cmp).astype(jnp.float32) * scale
    blk_end = jnp.arange(nc) * NSA_CMP_STRIDE + NSA_CMP_LEN - 1
    ok = blk_end[None, :] <= jnp.arange(S)[:, None]
    p = jnp.where(ok, jax.nn.softmax(jnp.where(ok, s, NEG), axis=-1), 0.0)
    o = jnp.einsum('bgjsn,bgnd->bgjsd', p.astype(v_cmp.dtype), v_cmp)
    return o, p


def nsa_select_blocks(p_cmp, S):
    nc = p_cmp.shape[-1]
    ns = S // NSA_SEL_LEN
    c_start = np.arange(nc) * NSA_CMP_STRIDE
    c_end = c_start + NSA_CMP_LEN
    s_start = np.arange(ns) * NSA_SEL_LEN
    s_end = s_start + NSA_SEL_LEN
    overlap = jnp.asarray(((c_start[:, None] < s_end[None, :]) &
                           (c_end[:, None] > s_start[None, :])).astype(np.float32))
    imp = jnp.einsum('bgjsn,nm->bgsm', p_cmp, overlap)
    t = jnp.arange(S)[:, None]
    m = jnp.arange(ns)[None, :]
    causal = m * NSA_SEL_LEN <= t
    cur = t // NSA_SEL_LEN
    forced = (m == 0) | (m == cur) | (m == cur - 1)
    score = jnp.where(causal, jnp.where(forced, FORCE, imp), -FORCE)
    val, idx = lax.top_k(score, min(NSA_SEL_TOPK, ns))
    return idx, val > -0.5 * FORCE


def nsa_selected_branch(q, ks, vs, sel_idx, sel_ok, scale):
    B, G, HG, S, dh = q.shape
    ns = S // NSA_SEL_LEN
    kk = sel_idx.shape[-1]
    Qc = NSA_SEL_QCHUNK
    nq = S // Qc
    k_blocks = ks.reshape(B, G, ns, NSA_SEL_LEN, dh)
    v_blocks = vs.reshape(B, G, ns, NSA_SEL_LEN, dh)
    q_ch = jnp.moveaxis(q.reshape(B, G, HG, nq, Qc, dh), 3, 0)
    i_ch = jnp.moveaxis(sel_idx.reshape(B, G, nq, Qc, kk), 2, 0)
    ok_ch = jnp.moveaxis(sel_ok.reshape(B, G, nq, Qc, kk), 2, 0)
    b_ix = jnp.arange(B)[:, None, None, None]
    g_ix = jnp.arange(G)[None, :, None, None]
    n_keys = kk * NSA_SEL_LEN

    def one(args):
        qc, ic, okc, c = args
        kg = k_blocks[b_ix, g_ix, ic].reshape(B, G, Qc, n_keys, dh)
        vg = v_blocks[b_ix, g_ix, ic].reshape(B, G, Qc, n_keys, dh)
        kpos = ic[..., None] * NSA_SEL_LEN + jnp.arange(NSA_SEL_LEN)
        qpos = c * Qc + jnp.arange(Qc)
        mask = (okc[..., None] & (kpos <= qpos[None, None, :, None, None])).reshape(B, G, Qc, n_keys)
        s = jnp.einsum('bgjqd,bgqkd->bgjqk', qc, kg).astype(jnp.float32) * scale
        p = jax.nn.softmax(jnp.where(mask[:, :, None], s, NEG), axis=-1)
        return jnp.einsum('bgjqk,bgqkd->bgjqd', p.astype(vg.dtype), vg)

    o = lax.map(one, (q_ch, i_ch, ok_ch, jnp.arange(nq)))
    return jnp.moveaxis(o, 0, 3).reshape(B, G, HG, S, dh)


def nsa_window_branch(q, kw, vw, scale):
    B, G, HG, S, dh = q.shape
    nb = S // Q_BLOCK
    span = NSA_WINDOW + Q_BLOCK
    pad = ((0, 0), (0, 0), (NSA_WINDOW, 0), (0, 0))
    k_pad = jnp.pad(kw, pad)
    v_pad = jnp.pad(vw, pad)
    q_b = jnp.moveaxis(q.reshape(B, G, HG, nb, Q_BLOCK, dh), 3, 0)

    def one(args):
        qb, i = args
        start = i * Q_BLOCK
        kb = lax.dynamic_slice_in_dim(k_pad, start, span, axis=2)
        vb = lax.dynamic_slice_in_dim(v_pad, start, span, axis=2)
        kpos = start - NSA_WINDOW + jnp.arange(span)
        qpos = start + jnp.arange(Q_BLOCK)
        mask = ((kpos[None, :] <= qpos[:, None]) & (kpos[None, :] > qpos[:, None] - NSA_WINDOW)
                & (kpos[None, :] >= 0))
        s = jnp.einsum('bgjqd,bgkd->bgjqk', qb, kb).astype(jnp.float32) * scale
        p = jax.nn.softmax(jnp.where(mask, s, NEG), axis=-1)
        return jnp.einsum('bgjqk,bgkd->bgjqd', p.astype(vb.dtype), vb)

    o = lax.map(one, (q_b, jnp.arange(nb)))
    return jnp.moveaxis(o, 0, 3).reshape(B, G, HG, S, dh)


def nsa_mixer(h, cos, sin, w_in, b_gate, cmp_pos, cmp_w1, cmp_w2, w_out):
    B, S, _ = h.shape
    G, HG, dh = NSA_KV_GROUPS, NSA_HPG, NSA_HEAD_DIM
    q, kc, vc, ks, vs, kw, vw, gl = split_cols(h @ w_in, NSA_SPLITS)
    q = apply_rope(q.reshape(B, S, G, HG, dh).transpose(0, 2, 3, 1, 4), cos[:, None, None], sin[:, None, None])

    def kvh(t):
        return t.reshape(B, S, G, dh).transpose(0, 2, 1, 3)

    kc = apply_rope(kvh(kc), cos[:, None], sin[:, None])
    ks = apply_rope(kvh(ks), cos[:, None], sin[:, None])
    kw = apply_rope(kvh(kw), cos[:, None], sin[:, None])
    vc, vs, vw = kvh(vc), kvh(vs), kvh(vw)
    scale = dh ** -0.5
    o_cmp, p_cmp = nsa_compressed_branch(q, kc, vc, cmp_pos, cmp_w1, cmp_w2, scale)
    sel_idx, sel_ok = nsa_select_blocks(p_cmp, S)
    o_sel = nsa_selected_branch(q, ks, vs, sel_idx, sel_ok, scale)
    o_win = nsa_window_branch(q, kw, vw, scale)
    gates = jax.nn.sigmoid((gl + b_gate).astype(jnp.float32)).reshape(B, S, G, HG, 3).transpose(0, 2, 3, 1, 4)
    o = gates[..., 0:1] * o_cmp + gates[..., 1:2] * o_sel + gates[..., 2:3] * o_win
    o = o.transpose(0, 3, 1, 2, 4).reshape(B, S, NSA_MIX).astype(h.dtype)
    return o @ w_out


def swiglu(h, w_gate, w_up, w_down):
    return (jax.nn.silu(h @ w_gate) * (h @ w_up)) @ w_down


def setup_inputs(seed: int = 0) -> dict:
    key = jax.random.key(seed)
    ks = jax.random.split(key, 32)
    f32 = jnp.float32
    NE = (DEPTH + 1) // 2
    NO = DEPTH // 2

    def nrm(k, shape, s):
        return jax.random.normal(k, shape, f32) * s

    def gain(k, shape):
        return 1.0 + 0.05 * jax.random.normal(k, shape, f32)

    return {
        "x": nrm(ks[0], (BATCH, SEQ, D_MODEL), 1.0),
        "p": nrm(ks[1], (DEPTH, BATCH, SEQ, PLE_DIM), 1.0),
        "positions": (jnp.arange(SEQ, dtype=jnp.int32)[None, :]
                      + jax.random.randint(ks[2], (BATCH, 1), 0, 1024, dtype=jnp.int32)),
        "ln_mix_pre": gain(ks[3], (DEPTH, D_MODEL)),
        "ln_mix_post": gain(ks[4], (DEPTH, D_MODEL)),
        "ln_ffn_pre": gain(ks[5], (DEPTH, D_MODEL)),
        "ln_ffn_post": gain(ks[6], (DEPTH, D_MODEL)),
        "ab_w_in": nrm(ks[7], (NE, D_MODEL, AB_IN), D_MODEL ** -0.5),
        "gla_w_alpha_up": nrm(ks[8], (NE, GLA_GATE_RANK, GLA_HEADS * GLA_DK), GLA_GATE_RANK ** -0.5),
        "gla_b_alpha": nrm(ks[9], (NE, GLA_HEADS * GLA_DK), 0.1),
        "gla_norm_w": gain(ks[10], (NE, GLA_DV)),
        "mla_q_norm_w": gain(ks[11], (NE, MLA_Q_RANK)),
        "mla_w_uq": nrm(ks[12], (NE, MLA_Q_RANK, MLA_HEADS * (MLA_NOPE + MLA_ROPE)), MLA_Q_RANK ** -0.5),
        "mla_kv_norm_w": gain(ks[13], (NE, MLA_KV_RANK)),
        "mla_w_ukv": nrm(ks[14], (NE, MLA_KV_RANK, MLA_HEADS * (MLA_NOPE + MLA_V)), MLA_KV_RANK ** -0.5),
        "ab_w_out": nrm(ks[15], (NE, AB_MIX, D_MODEL), AB_MIX ** -0.5),
        "nsa_w_in": nrm(ks[16], (NO, D_MODEL, NSA_IN), D_MODEL ** -0.5),
        "nsa_b_gate": nrm(ks[17], (NO, 3 * NSA_HEADS), 0.1),
        "nsa_cmp_pos": nrm(ks[18], (NO, 2, NSA_CMP_LEN, NSA_HEAD_DIM), 0.1),
        "nsa_cmp_w1": nrm(ks[19], (NO, 2, NSA_CMP_LEN * NSA_HEAD_DIM, NSA_HEAD_DIM),
                          (NSA_CMP_LEN * NSA_HEAD_DIM) ** -0.5),
        "nsa_cmp_w2": nrm(ks[20], (NO, 2, NSA_HEAD_DIM, NSA_HEAD_DIM), NSA_HEAD_DIM ** -0.5),
        "nsa_w_out": nrm(ks[21], (NO, NSA_MIX, D_MODEL), NSA_MIX ** -0.5),
        "ffn_w_gate": nrm(ks[22], (DEPTH, D_MODEL, FFN_HIDDEN), D_MODEL ** -0.5),
        "ffn_w_up": nrm(ks[23], (DEPTH, D_MODEL, FFN_HIDDEN), D_MODEL ** -0.5),
        "ffn_w_down": nrm(ks[24], (DEPTH, FFN_HIDDEN, D_MODEL), FFN_HIDDEN ** -0.5),
        "ple_w_gate": nrm(ks[25], (DEPTH, D_MODEL, D_MODEL), D_MODEL ** -0.5),
        "ple_b_gate": nrm(ks[26], (DEPTH, D_MODEL), 0.01),
        "ple_w_proj": nrm(ks[27], (DEPTH, PLE_DIM, D_MODEL), PLE_DIM ** -0.5),
    }


def reference(x, p, positions, ln_mix_pre, ln_mix_post, ln_ffn_pre, ln_ffn_post,
              ab_w_in, gla_w_alpha_up, gla_b_alpha, gla_norm_w, mla_q_norm_w, mla_w_uq,
              mla_kv_norm_w, mla_w_ukv, ab_w_out,
              nsa_w_in, nsa_b_gate, nsa_cmp_pos, nsa_cmp_w1, nsa_cmp_w2, nsa_w_out,
              ffn_w_gate, ffn_w_up, ffn_w_down, ple_w_gate, ple_b_gate, ple_w_proj):
    cos64, sin64 = rope_tables(positions, MLA_ROPE)
    cos128, sin128 = rope_tables(positions, NSA_HEAD_DIM)
    h = x
    for i in range(DEPTH):
        hn = rms_norm(h, ln_mix_pre[i])
        if i % 2 == 0:
            j = i // 2
            m = gla_mla_mixer(hn, cos64, sin64, ab_w_in[j], gla_w_alpha_up[j], gla_b_alpha[j],
                              gla_norm_w[j], mla_q_norm_w[j], mla_w_uq[j], mla_kv_norm_w[j],
                              mla_w_ukv[j], ab_w_out[j])
        else:
            j = i // 2
            m = nsa_mixer(hn, cos128, sin128, nsa_w_in[j], nsa_b_gate[j], nsa_cmp_pos[j],
                          nsa_cmp_w1[j], nsa_cmp_w2[j], nsa_w_out[j])
        h = h + rms_norm(m, ln_mix_post[i])
        f = swiglu(rms_norm(h, ln_ffn_pre[i]), ffn_w_gate[i], ffn_w_up[i], ffn_w_down[i])
        h = h + rms_norm(f, ln_ffn_post[i])
        gate = jax.nn.sigmoid(h @ ple_w_gate[i] + ple_b_gate[i])
        h = h + gate * (p[i] @ ple_w_proj[i])
    return h
```

```cpp
#include <hip/hip_runtime.h>
#include <hip/hip_cooperative_groups.h>
#include <cstdio>
#include <cstdint>
namespace cg = cooperative_groups;

typedef unsigned short bf16_t;
typedef short bf16x8 __attribute__((ext_vector_type(8)));
typedef short s16x4 __attribute__((ext_vector_type(4)));
typedef float f32x4 __attribute__((ext_vector_type(4)));
typedef unsigned u32x4 __attribute__((ext_vector_type(4)));
typedef unsigned u32x2 __attribute__((ext_vector_type(2)));
#define DI __device__ __forceinline__
#define LDSP(T, p) ((__attribute__((address_space(3))) T*)(p))

constexpr int TOK = 8192, SEQ = 2048, DM = 2048, NB = 4;
constexpr int ABN = 4176, ABP = 4224;
constexpr int NSN = 5168, NSP = 5248;
constexpr int FH = 5632;
constexpr int QS_MLA = 2, QS_CW = 2, QS_SEL = 2;
#define QB (64 * QS)
#define NQT (SEQ / QB)
constexpr int ZQ = 0, ZK = 512, ZV = 1024, ZG = 2048, ZA = 3072, ZCQ = 3088, ZCKV = 3600, ZKR = 4112;
constexpr int NQ = 0, NKC = 2048, NVC = 2560, NKS = 3072, NVS = 3584, NKW = 4096, NVW = 4608, NGL = 5120;

constexpr size_t al(size_t x) { return (x + 255) & ~(size_t)255; }
constexpr size_t W_ABIN = 0;
constexpr size_t W_UQ = W_ABIN + al((size_t)2 * ABP * 2048 * 2);
constexpr size_t W_UKV = W_UQ + al((size_t)2 * 1536 * 512 * 2);
constexpr size_t W_ABOUT = W_UKV + al((size_t)2 * 2048 * 512 * 2);
constexpr size_t W_NSIN = W_ABOUT + al((size_t)2 * 2048 * 2048 * 2);
constexpr size_t W_W1 = W_NSIN + al((size_t)2 * NSP * 2048 * 2);
constexpr size_t W_W2 = W_W1 + al((size_t)4 * 128 * 4096 * 2);
constexpr size_t W_NSOUT = W_W2 + al((size_t)4 * 128 * 128 * 2);
constexpr size_t W_FGU = W_NSOUT + al((size_t)2 * 2048 * 2048 * 2);
constexpr size_t W_FD = W_FGU + al((size_t)4 * 11264 * 2048 * 2);
constexpr size_t W_PG = W_FD + al((size_t)4 * 2048 * 5632 * 2);
constexpr size_t W_PP = W_PG + al((size_t)4 * 2048 * 2048 * 2);
constexpr size_t A_PBF = W_PP + al((size_t)4 * 2048 * 256 * 2);
constexpr size_t A_H = A_PBF + al((size_t)4 * TOK * 256 * 2);
constexpr size_t A_HN = A_H + al((size_t)TOK * 2048 * 4);
constexpr size_t A_MIX = A_HN + al((size_t)TOK * 2048 * 2);
constexpr size_t A_MB = A_MIX + al((size_t)TOK * 2048 * 2);
constexpr size_t A_R1 = A_MB + al((size_t)TOK * 2048 * 4);
constexpr size_t A_R3 = A_R1 + al((size_t)TOK * 5632 * 2);
constexpr size_t A_R4 = A_R3 + al((size_t)4 * 16 * 2048 * 128 * 4);
constexpr size_t A_R5 = A_R4 + al((size_t)2 * 2048 * 4096 * 2);
constexpr size_t A_KR = A_R5 + al((size_t)2 * TOK * 512 * 2);
constexpr size_t A_SEL = A_KR + al((size_t)TOK * 64 * 2);
constexpr size_t A_BAR = A_SEL + al((size_t)16 * 2048 * 4);
constexpr size_t A_RSS = A_BAR + al((size_t)4096 * 4);
constexpr size_t WS_NEED = A_RSS + al((size_t)TOK * 16 * 4);

struct Params {
  const float* in[28];
  float* out;
  char* ws;
};

DI float bf2f(bf16_t v) { return __uint_as_float(((unsigned)v) << 16); }
DI unsigned pack2(float lo, float hi) { unsigned r; asm("v_cvt_pk_bf16_f32 %0, %1, %2" : "=v"(r) : "v"(lo), "v"(hi)); return r; }
DI bf16_t f2bf(float f) { return (bf16_t)(pack2(f, 0.f) & 0xffffu); }
DI float lo2f(unsigned u) { return __uint_as_float(u << 16); }
DI float hi2f(unsigned u) { return __uint_as_float(u & 0xffff0000u); }
DI float wave_sum(float v) {
#pragma unroll
  for (int o = 32; o > 0; o >>= 1) v += __shfl_xor(v, o);
  return v;
}
DI int tidx() { int t = threadIdx.x; asm volatile("" : "+v"(t)); return t; }
DI f32x4 zero4() { float z0 = 0.f; asm volatile("" : "+v"(z0)); return (f32x4){z0, z0, z0, z0}; }
DI float sigmoidf_(float x) { return 1.f / (1.f + __expf(-x)); }
DI void rope_cs(int pos, int i, float l2step, float& c, float& s) {
  float inv = exp2f(-(float)i * l2step);
  float ang = (float)pos * inv;
  float rev = ang * 0.15915494309189535f;
  rev -= floorf(rev);
  c = __builtin_amdgcn_cosf(rev);
  s = __builtin_amdgcn_sinf(rev);
}

DI void transpose_job(const float* __restrict__ src, int K, int N, int Npad, bf16_t* __restrict__ dst, int mode, char* smem) {
  float* t = (float*)smem;
  const int tn = Npad / 64, tk = K / 64, tid = tidx();
  for (int tile = blockIdx.x; tile < tn * tk; tile += gridDim.x) {
    const int n0 = (tile % tn) * 64, k0 = (tile / tn) * 64;
#pragma unroll
    for (int i = 0; i < 4; ++i) {
      const int kr = (tid >> 4) + 16 * i, nc = (tid & 15) * 4, n = n0 + nc;
      float4 v = make_float4(0.f, 0.f, 0.f, 0.f);
      if (n < N) { const f32x4 t4 = __builtin_nontemporal_load((const f32x4*)(src + (size_t)(k0 + kr) * N + n)); v = make_float4(t4[0], t4[1], t4[2], t4[3]); }
      t[kr * 65 + nc + 0] = v.x; t[kr * 65 + nc + 1] = v.y; t[kr * 65 + nc + 2] = v.z; t[kr * 65 + nc + 3] = v.w;
    }
    __syncthreads();
    {
      const int nr = tid >> 2, kq = (tid & 3) * 16, n = n0 + nr;
      unsigned w[8];
#pragma unroll
      for (int e = 0; e < 8; ++e) w[e] = pack2(t[(kq + 2 * e) * 65 + nr], t[(kq + 2 * e + 1) * 65 + nr]);
      int row = n;
      if (mode == 1) row = (n >> 6) * 128 + (n & 63);
      else if (mode == 2) row = (n >> 6) * 128 + 64 + (n & 63);
      u32x4* d = (u32x4*)(dst + (size_t)row * K + k0 + kq);
      __builtin_nontemporal_store((u32x4){w[0], w[1], w[2], w[3]}, d);
      __builtin_nontemporal_store((u32x4){w[4], w[5], w[6], w[7]}, d + 1);
    }
    __syncthreads();
  }
}

DI void row_pass(const float* __restrict__ init, const bf16_t* __restrict__ add, const float* __restrict__ wpost,
                         float* __restrict__ h, const float* __restrict__ wnext, bf16_t* __restrict__ hn, float* __restrict__ zero_rss = nullptr) {
  const int tid = tidx(), lane = tid & 63, wv = tid >> 6;
  for (int row = blockIdx.x * 4 + wv; row < TOK; row += gridDim.x * 4) {
    const size_t ro = (size_t)row * DM;
    if (zero_rss && lane == 0) zero_rss[row] = 0.f;
    float4 hv[8];
    const float* hs = init ? init : h;
#pragma unroll
    for (int i = 0; i < 8; ++i) hv[i] = *(const float4*)(hs + ro + i * 256 + lane * 4);
    if (add) {
      float4 av[8]; float ss = 0.f;
#pragma unroll
      for (int i = 0; i < 8; ++i) { const u32x2 a2 = *(const u32x2*)(add + ro + i * 256 + lane * 4); av[i] = make_float4(lo2f(a2[0]), hi2f(a2[0]), lo2f(a2[1]), hi2f(a2[1])); ss += av[i].x * av[i].x + av[i].y * av[i].y + av[i].z * av[i].z + av[i].w * av[i].w; }
      ss = wave_sum(ss);
      const float r = rsqrtf(ss * (1.f / DM) + 1e-6f);
#pragma unroll
      for (int i = 0; i < 8; ++i) {
        const float4 w = *(const float4*)(wpost + i * 256 + lane * 4);
        hv[i].x += av[i].x * r * w.x; hv[i].y += av[i].y * r * w.y; hv[i].z += av[i].z * r * w.z; hv[i].w += av[i].w * r * w.w;
      }
    }
    if (add || init) {
#pragma unroll
      for (int i = 0; i < 8; ++i) *(float4*)(h + ro + i * 256 + lane * 4) = hv[i];
    }
    float r2 = 1.f;
    if (wnext) {
      float ss = 0.f;
#pragma unroll
      for (int i = 0; i < 8; ++i) ss += hv[i].x * hv[i].x + hv[i].y * hv[i].y + hv[i].z * hv[i].z + hv[i].w * hv[i].w;
      ss = wave_sum(ss);
      r2 = rsqrtf(ss * (1.f / DM) + 1e-6f);
    }
#pragma unroll
    for (int i = 0; i < 8; ++i) {
      float4 w = make_float4(1.f, 1.f, 1.f, 1.f);
      if (wnext) w = *(const float4*)(wnext + i * 256 + lane * 4);
      uint2 o; o.x = pack2(hv[i].x * r2 * w.x, hv[i].y * r2 * w.y); o.y = pack2(hv[i].z * r2 * w.z, hv[i].w * r2 * w.w);
      *(uint2*)(hn + ro + i * 256 + lane * 4) = o;
    }
  }
}

DI int toff(int row, int chunk) { return row * 128 + ((chunk ^ ((row >> 1) & 7)) << 4); }

DI void gemm_issue_first(const bf16_t* __restrict__ A, int lda, const bf16_t* __restrict__ Bt, int ldb, int m0, int n0, char* smem) {
  const int tid = tidx(), wave = tid >> 6, lane = tid & 63;
#pragma unroll
  for (int i = 0; i < 4; ++i) {
    const int row = (i * 4 + wave) * 8 + (lane >> 3), chunk = (lane & 7) ^ ((row >> 1) & 7);
    __builtin_amdgcn_global_load_lds((const unsigned*)(A + (size_t)(m0 + row) * lda + chunk * 8), LDSP(unsigned, smem + (i * 4 + wave) * 1024), 16, 0, 0);
    __builtin_amdgcn_global_load_lds((const unsigned*)(Bt + (size_t)(n0 + row) * ldb + chunk * 8), LDSP(unsigned, smem + 16384 + (i * 4 + wave) * 1024), 16, 0, 0);
  }
}
#define DSR(dst, addr, off) asm volatile("ds_read_b128 %0, %1 offset:%2" : "=v"(dst) : "v"(addr), "n"(off) : "memory")
template <bool DEEP = false>
DI void gemm_mainloop(const bf16_t* __restrict__ A, int lda, const bf16_t* __restrict__ Bt, int ldb, int K, int m0, int n0,
                      f32x4 (&acc)[2][8], char* smem, bool prefetched = false) {
  const int tid = tidx(), wave = tid >> 6, lane = tid & 63;
  const bf16_t* ag[4]; const bf16_t* bg[4];
#pragma unroll
  for (int i = 0; i < 4; ++i) {
    const int row = (i * 4 + wave) * 8 + (lane >> 3), chunk = (lane & 7) ^ ((row >> 1) & 7);
    ag[i] = A + (size_t)(m0 + row) * lda + chunk * 8;
    bg[i] = Bt + (size_t)(n0 + row) * ldb + chunk * 8;
  }
  const int nk = K >> 6;
#define GSTAGE(buf, kt)                                                                                                   \
  _Pragma("unroll") for (int i = 0; i < 4; ++i) {                                                                         \
    __builtin_amdgcn_global_load_lds((const unsigned*)(ag[i] + (kt) * 64), LDSP(unsigned, smem + (buf) * 32768 + (i * 4 + wave) * 1024), 16, 0, 0);          \
    __builtin_amdgcn_global_load_lds((const unsigned*)(bg[i] + (kt) * 64), LDSP(unsigned, smem + (buf) * 32768 + 16384 + (i * 4 + wave) * 1024), 16, 0, 0);  \
  }
  if (!prefetched) { GSTAGE(0, 0); }
  asm volatile("s_waitcnt vmcnt(0)" ::: "memory");
  __syncthreads();
#pragma unroll 1
  for (int kt = 0; kt < nk; ++kt) {
    const int cur = kt & 1;
    if (kt + 1 < nk) { GSTAGE(cur ^ 1, kt + 1); }
    const char* As = smem + cur * 32768; const char* Bs = As + 16384;
    if (DEEP) {
      const unsigned i16 = lane & 15, gq = lane >> 4, sw = (i16 >> 1) & 7;
      const unsigned base = (unsigned)(size_t)smem + cur * 32768 + i16 * 128;
      const unsigned a0 = base + wave * 4096 + ((gq ^ sw) << 4), a1 = base + wave * 4096 + (((4 + gq) ^ sw) << 4);
      const unsigned b0 = base + 16384 + ((gq ^ sw) << 4), b1 = base + 16384 + (((4 + gq) ^ sw) << 4);
      bf16x8 af[2][2], bfr[2][8];
      DSR(af[0][0], a0, 0); DSR(af[0][1], a0, 2048);
      DSR(bfr[0][0], b0, 0); DSR(bfr[0][1], b0, 2048); DSR(bfr[0][2], b0, 4096); DSR(bfr[0][3], b0, 6144);
      DSR(bfr[0][4], b0, 8192); DSR(bfr[0][5], b0, 10240); DSR(bfr[0][6], b0, 12288); DSR(bfr[0][7], b0, 14336);
      DSR(af[1][0], a1, 0); DSR(af[1][1], a1, 2048);
      DSR(bfr[1][0], b1, 0); DSR(bfr[1][1], b1, 2048); DSR(bfr[1][2], b1, 4096); DSR(bfr[1][3], b1, 6144);
      DSR(bfr[1][4], b1, 8192); DSR(bfr[1][5], b1, 10240); DSR(bfr[1][6], b1, 12288); DSR(bfr[1][7], b1, 14336);
      __builtin_amdgcn_sched_barrier(0);
      asm volatile("s_waitcnt lgkmcnt(10)" ::: "memory");
      __builtin_amdgcn_sched_barrier(0);
#pragma unroll
      for (int mi = 0; mi < 2; ++mi)
#pragma unroll
        for (int ni = 0; ni < 8; ++ni) acc[mi][ni] = __builtin_amdgcn_mfma_f32_16x16x32_bf16(bfr[0][ni], af[0][mi], acc[mi][ni], 0, 0, 0);
      __builtin_amdgcn_sched_barrier(0);
      asm volatile("s_waitcnt lgkmcnt(0)" ::: "memory");
      __builtin_amdgcn_sched_barrier(0);
#pragma unroll
      for (int mi = 0; mi < 2; ++mi)
#pragma unroll
        for (int ni = 0; ni < 8; ++ni) acc[mi][ni] = __builtin_amdgcn_mfma_f32_16x16x32_bf16(bfr[1][ni], af[1][mi], acc[mi][ni], 0, 0, 0);
      __builtin_amdgcn_sched_barrier(0);
    } else
#pragma unroll
    for (int ks = 0; ks < 2; ++ks) {
      const int chunk = ks * 4 + (lane >> 4);
      bf16x8 af[2], bfr[8];
#pragma unroll
      for (int mi = 0; mi < 2; ++mi) af[mi] = *(const bf16x8*)(As + toff(wave * 32 + mi * 16 + (lane & 15), chunk));
#pragma unroll
      for (int ni = 0; ni < 8; ++ni) bfr[ni] = *(const bf16x8*)(Bs + toff(ni * 16 + (lane & 15), chunk));
#pragma unroll
      for (int mi = 0; mi < 2; ++mi)
#pragma unroll
        for (int ni = 0; ni < 8; ++ni) acc[mi][ni] = __builtin_amdgcn_mfma_f32_16x16x32_bf16(bfr[ni], af[mi], acc[mi][ni], 0, 0, 0);
    }
    asm volatile("s_waitcnt vmcnt(0)" ::: "memory");
    __syncthreads();
  }
#undef GSTAGE
}
DI void gemm_mainloop_deep(const bf16_t* __restrict__ A, int lda, const bf16_t* __restrict__ Bt, int ldb, int K, int m0, int n0,
                           f32x4 (&acc)[2][8], char* smem, bool prefetched) {
  const int tid = tidx(), wave = tid >> 6, lane = tid & 63;
  const bf16_t* ag[4]; const bf16_t* bg[4];
#pragma unroll
  for (int i = 0; i < 4; ++i) {
    const int row = (i * 4 + wave) * 8 + (lane >> 3), chunk = (lane & 7) ^ ((row >> 1) & 7);
    ag[i] = A + (size_t)(m0 + row) * lda + chunk * 8;
    bg[i] = Bt + (size_t)(n0 + row) * ldb + chunk * 8;
  }
  const int nk = K >> 6;
#define GSTAGE(buf, kt)                                                                                                   \
  _Pragma("unroll") for (int i = 0; i < 4; ++i) {                                                                         \
    __builtin_amdgcn_global_load_lds((const unsigned*)(ag[i] + (kt) * 64), LDSP(unsigned, smem + (buf) * 32768 + (i * 4 + wave) * 1024), 16, 0, 0);          \
    __builtin_amdgcn_global_load_lds((const unsigned*)(bg[i] + (kt) * 64), LDSP(unsigned, smem + (buf) * 32768 + 16384 + (i * 4 + wave) * 1024), 16, 0, 0);  \
  }
#define RDSET(S, abase, bbase)                                                                                            \
  DSR(af[S][0], abase, 0); DSR(af[S][1], abase, 2048);                                                                    \
  DSR(bfr[S][0], bbase, 0); DSR(bfr[S][1], bbase, 2048); DSR(bfr[S][2], bbase, 4096); DSR(bfr[S][3], bbase, 6144);        \
  DSR(bfr[S][4], bbase, 8192); DSR(bfr[S][5], bbase, 10240); DSR(bfr[S][6], bbase, 12288); DSR(bfr[S][7], bbase, 14336);
#define MMSET(S)                                                                                                          \
  _Pragma("unroll") for (int mi = 0; mi < 2; ++mi)                                                                        \
  _Pragma("unroll") for (int ni = 0; ni < 8; ++ni) acc[mi][ni] = __builtin_amdgcn_mfma_f32_16x16x32_bf16(bfr[S][ni], af[S][mi], acc[mi][ni], 0, 0, 0);
  const unsigned i16 = lane & 15, gq = lane >> 4, sw = (i16 >> 1) & 7;
  const unsigned lb = (unsigned)(size_t)smem + i16 * 128;
  const unsigned o0 = (gq ^ sw) << 4, o1 = ((4 + gq) ^ sw) << 4;
  bf16x8 af[2][2], bfr[2][8];
  if (!prefetched) { GSTAGE(0, 0); }
  asm volatile("s_waitcnt vmcnt(0)" ::: "memory");
  __syncthreads();
  if (nk > 1) { GSTAGE(1, 1); }
  { const unsigned a = lb + wave * 4096 + o0, b = lb + 16384 + o0; RDSET(0, a, b); }
#pragma unroll 1
  for (int kt = 0; kt < nk; ++kt) {
    const unsigned cb = lb + (kt & 1) * 32768, nb = lb + ((kt & 1) ^ 1) * 32768;
    { const unsigned a = cb + wave * 4096 + o1, b = cb + 16384 + o1; RDSET(1, a, b); }
    __builtin_amdgcn_sched_barrier(0);
    asm volatile("s_waitcnt lgkmcnt(10)" ::: "memory");
    __builtin_amdgcn_sched_barrier(0);
    MMSET(0)
    __builtin_amdgcn_sched_barrier(0);
    asm volatile("s_waitcnt lgkmcnt(0)\n\ts_waitcnt vmcnt(0)" ::: "memory");
    __syncthreads();
    __builtin_amdgcn_sched_barrier(0);
    if (kt + 2 < nk) { GSTAGE(kt & 1, kt + 2); }
    if (kt + 1 < nk) { const unsigned a = nb + wave * 4096 + o0, b = nb + 16384 + o0; RDSET(0, a, b); }
    __builtin_amdgcn_sched_barrier(0);
    MMSET(1)
    __builtin_amdgcn_sched_barrier(0);
  }
#undef GSTAGE
#undef RDSET
#undef MMSET
}

enum { EPI_BF16 = 0, EPI_F32 = 1, EPI_SWIGLU = 2, EPI_GELU = 3, EPI_PLE = 4 };
struct GArgs {
  const bf16_t* A; int lda; const bf16_t* Bt; int K; int M; int Npad;
  void* C; int ldc;
  const bf16_t* A2; int lda2; const bf16_t* Bt2; int K2;
  const float* bias; const float* hsrc;
  const float* wnext; bf16_t* hnext; float* rss;
  const float* rowss;
};
DI float gelu_tanh(float x) {
  const float u = 0.7978845608028654f * (x + 0.044715f * x * x * x);
  const float t = 1.f - 2.f / (1.f + __expf(2.f * u));
  return 0.5f * x * (1.f + t);
}
template <int EPI>
DI void gemm_phase(const GArgs& g, char* smem) {
  const int ntm = g.M / 128, ntn = g.Npad / 128;
  const int tid = tidx(), lane = tid & 63, wave = tid >> 6;
  if (EPI != EPI_PLE && (int)blockIdx.x < ntm * ntn) gemm_issue_first(g.A, g.lda, g.Bt, g.K, (blockIdx.x % ntm) * 128, (blockIdx.x / ntm) * 128, smem);
  for (int tile = blockIdx.x; tile < ntm * ntn; tile += gridDim.x) {
    const int m0 = (tile % ntm) * 128, n0 = (tile / ntm) * 128;
    f32x4 acc[2][8];
#pragma unroll
    for (int mi = 0; mi < 2; ++mi)
#pragma unroll
      for (int ni = 0; ni < 8; ++ni) acc[mi][ni] = zero4();
    if (EPI != EPI_PLE) gemm_mainloop_deep(g.A, g.lda, g.Bt, g.K, g.K, m0, n0, acc, smem, true);
    else gemm_mainloop<false>(g.A, g.lda, g.Bt, g.K, g.K, m0, n0, acc, smem, false);
    if (EPI != EPI_PLE) {
      const int nt = tile + gridDim.x;
      if (nt < ntm * ntn) gemm_issue_first(g.A, g.lda, g.Bt, g.K, (nt % ntm) * 128, (nt / ntm) * 128, smem);
    }
    if (EPI == EPI_PLE) {
      f32x4 acc2[2][8];
#pragma unroll
      for (int mi = 0; mi < 2; ++mi)
#pragma unroll
        for (int ni = 0; ni < 8; ++ni) acc2[mi][ni] = zero4();
      gemm_mainloop(g.A2, g.lda2, g.Bt2, g.K2, g.K2, m0, n0, acc2, smem);
#pragma unroll
      for (int mi = 0; mi < 2; ++mi) {
        const int row = m0 + wave * 32 + mi * 16 + (lane & 15);
        float ssq = 0.f;
#pragma unroll
        for (int ni = 0; ni < 8; ++ni) {
          const int col = n0 + ni * 16 + (lane >> 4) * 4;
          const float4 hb = *(const float4*)(g.hsrc + (size_t)row * DM + col);
          const float4 bb = *(const float4*)(g.bias + col);
          float4 o;
          o.x = hb.x + sigmoidf_(acc[mi][ni][0] + bb.x) * acc2[mi][ni][0];
          o.y = hb.y + sigmoidf_(acc[mi][ni][1] + bb.y) * acc2[mi][ni][1];
          o.z = hb.z + sigmoidf_(acc[mi][ni][2] + bb.z) * acc2[mi][ni][2];
          o.w = hb.w + sigmoidf_(acc[mi][ni][3] + bb.w) * acc2[mi][ni][3];
          *(float4*)((float*)g.C + (size_t)row * DM + col) = o;
          if (g.hnext) {
            const float4 wn = *(const float4*)(g.wnext + col);
            u32x2 hb2; hb2[0] = pack2(o.x * wn.x, o.y * wn.y); hb2[1] = pack2(o.z * wn.z, o.w * wn.w);
            *(u32x2*)(g.hnext + (size_t)row * DM + col) = hb2;
            ssq += o.x * o.x + o.y * o.y + o.z * o.z + o.w * o.w;
          }
        }
        if (g.hnext) {
          ssq += __shfl_xor(ssq, 16); ssq += __shfl_xor(ssq, 32);
          if (lane < 16) g.rss[(size_t)row * 16 + (n0 >> 7)] = ssq;
        }
      }
    } else {
#pragma unroll
      for (int mi = 0; mi < 2; ++mi) {
        const int row = m0 + wave * 32 + mi * 16 + (lane & 15);
        float rsc = 1.f;
        if (EPI == EPI_BF16) {
          if (g.rowss) {
            const f32x4* rp = (const f32x4*)(g.rowss + (size_t)row * 16);
            const f32x4 a0 = rp[0], a1 = rp[1], a2 = rp[2], a3 = rp[3];
            const float tot = ((a0[0] + a0[1]) + (a0[2] + a0[3])) + ((a1[0] + a1[1]) + (a1[2] + a1[3])) + ((a2[0] + a2[1]) + (a2[2] + a2[3])) + ((a3[0] + a3[1]) + (a3[2] + a3[3]));
            rsc = rsqrtf(tot * (1.f / DM) + 1e-6f);
          }
        }
        if (EPI == EPI_SWIGLU) {
#pragma unroll
          for (int ni = 0; ni < 4; ++ni) {
            const int col = (n0 >> 1) + ni * 16 + (lane >> 4) * 4;
            float v[4];
#pragma unroll
            for (int r = 0; r < 4; ++r) { const float gt = acc[mi][ni][r]; v[r] = gt * sigmoidf_(gt) * acc[mi][ni + 4][r]; }
            uint2 o; o.x = pack2(v[0], v[1]); o.y = pack2(v[2], v[3]);
            *(uint2*)((bf16_t*)g.C + (size_t)row * g.ldc + col) = o;
          }
        } else {
#pragma unroll
          for (int ni = 0; ni < 8; ++ni) {
            const int col = n0 + ni * 16 + (lane >> 4) * 4;
            if (EPI == EPI_F32) {
              *(f32x4*)((float*)g.C + (size_t)row * g.ldc + col) = acc[mi][ni];
            } else {
              float v[4];
#pragma unroll
              for (int r = 0; r < 4; ++r) v[r] = (EPI == EPI_GELU) ? gelu_tanh(acc[mi][ni][r]) : acc[mi][ni][r] * rsc;
              uint2 o; o.x = pack2(v[0], v[1]); o.y = pack2(v[2], v[3]);
              *(uint2*)((bf16_t*)g.C + (size_t)row * g.ldc + col) = o;
            }
          }
        }
      }
    }
  }
}

DI void gemm_tail_splitk(const bf16_t* __restrict__ A, const bf16_t* __restrict__ Bt_tail, float* __restrict__ slab, char* smem) {
  const int tid = tidx(), lane = tid & 63, wave = tid >> 6;
  for (int u = blockIdx.x; u < 512; u += gridDim.x) {
    const int mt = u & 63, ks = u >> 6;
    f32x4 acc[2][8];
#pragma unroll
    for (int mi = 0; mi < 2; ++mi)
#pragma unroll
      for (int ni = 0; ni < 8; ++ni) acc[mi][ni] = zero4();
    gemm_mainloop(A + ks * 256, DM, Bt_tail + ks * 256, DM, 256, mt * 128, 0, acc, smem);
#pragma unroll
    for (int mi = 0; mi < 2; ++mi) {
      const int row = mt * 128 + wave * 32 + mi * 16 + (lane & 15);
#pragma unroll
      for (int ni = 0; ni < 8; ++ni) *(f32x4*)(slab + ((size_t)ks * TOK + row) * 128 + ni * 16 + (lane >> 4) * 4) = acc[mi][ni];
    }
  }
}
DI float row_rsc(const float* __restrict__ rowss, int row) {
  if (!rowss) return 1.f;
  const f32x4* rp = (const f32x4*)(rowss + (size_t)row * 16);
  const f32x4 a0 = rp[0], a1 = rp[1], a2 = rp[2], a3 = rp[3];
  const float tot = ((a0[0] + a0[1]) + (a0[2] + a0[3])) + ((a1[0] + a1[1]) + (a1[2] + a1[3])) + ((a2[0] + a2[1]) + (a2[2] + a2[3])) + ((a3[0] + a3[1]) + (a3[2] + a3[3]));
  return rsqrtf(tot * (1.f / DM) + 1e-6f);
}
DI float slab_sum(const float* __restrict__ slab, int tok, int col) {
  float v = 0.f;
#pragma unroll
  for (int ks = 0; ks < 8; ++ks) v += slab[((size_t)ks * TOK + tok) * 128 + col];
  return v;
}

template <bool WANT_Q>
DI void gla_prologue(int tid, const bf16_t* __restrict__ z, size_t tok0, int h, const float (&wu)[16], float ba,
                     float* qdT, float* kiT, float* alr, float* seg, float* Ed) {
  const int d_ = tid & 63, sg = tid >> 6;
  {
    const int t = tid >> 2, q4 = (tid & 3) * 4;
    const u32x2 av = *(const u32x2*)(z + (tok0 + t) * ABP + ZA + q4);
    *(f32x4*)(alr + t * 16 + q4) = (f32x4){lo2f(av[0]), hi2f(av[0]), lo2f(av[1]), hi2f(av[1])};
  }
  __syncthreads();
  float bb[16];
  {
    float run = 0.f;
#pragma unroll
    for (int i = 0; i < 16; ++i) {
      const int t = sg * 16 + i;
      float x = ba;
#pragma unroll
      for (int r = 0; r < 16; ++r) x += alr[t * 16 + r] * wu[r];
      const float ls = fminf(x, 0.f) - log1pf(__expf(-fabsf(x)));
      run += ls * (1.f / 16.f);
      bb[i] = run;
    }
    seg[sg * 64 + d_] = run;
  }
  __syncthreads();
  {
    float pre = 0.f, tot = 0.f;
#pragma unroll
    for (int s2 = 0; s2 < 4; ++s2) { const float v = seg[s2 * 64 + d_]; tot += v; if (s2 < sg) pre += v; }
    if (sg == 0) Ed[d_] = __expf(tot);
#pragma unroll
    for (int i = 0; i < 16; ++i) {
      const int t = sg * 16 + i;
      const float bt = bb[i] + pre;
      if (WANT_Q) qdT[d_ * 68 + t] = bf2f(z[(tok0 + t) * ABP + ZQ + h * 64 + d_]) * 0.125f * __expf(bt);
      kiT[d_ * 68 + t] = bf2f(z[(tok0 + t) * ABP + ZK + h * 64 + d_]) * __expf(-bt);
    }
  }
  __syncthreads();
}

DI void gla_pass2(float* __restrict__ Ubuf, const float* __restrict__ Ebuf) {
  const int idx = blockIdx.x * 256 + tidx();
  if (idx < 32 * 64 * 32) {
    const int bh = idx >> 11, d = (idx >> 5) & 63, v4 = idx & 31;
    f32x4 S = (f32x4){0.f, 0.f, 0.f, 0.f};
#pragma unroll 8
    for (int n = 0; n < 32; ++n) {
      float* p = Ubuf + (((size_t)bh * 32 + n) * 64 + d) * 128 + v4 * 4;
      const f32x4 u = *(const f32x4*)p;
      const float e = Ebuf[((size_t)bh * 32 + n) * 64 + d];
      *(f32x4*)p = S;
      S = e * (S + u);
    }
  }
}

DI void mla_prep(int first, int stride, const bf16_t* __restrict__ z, const float* __restrict__ qnw, const float* __restrict__ kvnw,
                         const int* __restrict__ pos, bf16_t* __restrict__ cqn, bf16_t* __restrict__ ckvn, bf16_t* __restrict__ krope,
                         const float* __restrict__ slab, const float* __restrict__ rowss) {
  const int tid = tidx(), lane = tid & 63, wv = tid >> 6;
  for (int tok = first * 4 + wv; tok < TOK; tok += stride * 4) {
    const bf16_t* zr = z + (size_t)tok * ABP;
    const float rsc = row_rsc(rowss, tok);
#pragma unroll
    for (int part = 0; part < 2; ++part) {
      const uint4 v = *(const uint4*)(zr + (part ? ZCKV : ZCQ) + lane * 8);
      float x[8] = {lo2f(v.x), hi2f(v.x), lo2f(v.y), hi2f(v.y), lo2f(v.z), hi2f(v.z), lo2f(v.w), hi2f(v.w)};
      if (part == 1 && lane >= 62) {
#pragma unroll
        for (int e = 0; e < 8; ++e) x[e] = slab_sum(slab, tok, (lane - 62) * 8 + e) * rsc;
      }
      float ss = 0.f;
#pragma unroll
      for (int e = 0; e < 8; ++e) ss += x[e] * x[e];
      ss = wave_sum(ss);
      const float r = rsqrtf(ss * (1.f / 512.f) + 1e-6f);
      const float* w = (part ? kvnw : qnw) + lane * 8;
      uint4 o;
      o.x = pack2(x[0] * r * w[0], x[1] * r * w[1]); o.y = pack2(x[2] * r * w[2], x[3] * r * w[3]);
      o.z = pack2(x[4] * r * w[4], x[5] * r * w[5]); o.w = pack2(x[6] * r * w[6], x[7] * r * w[7]);
      *(uint4*)((part ? ckvn : cqn) + (size_t)tok * 512 + lane * 8) = o;
    }
    if (lane < 32) {
      float c, s; rope_cs(pos[tok], lane, 13.287712379549449f / 32.f, c, s);
      const float x1 = slab_sum(slab, tok, 16 + lane) * rsc, x2 = slab_sum(slab, tok, 48 + lane) * rsc;
      krope[(size_t)tok * 64 + lane] = f2bf(x1 * c - x2 * s);
      krope[(size_t)tok * 64 + 32 + lane] = f2bf(x2 * c + x1 * s);
    }
  }
}

DI void gla_post(const float* __restrict__ ogla, const bf16_t* __restrict__ z, const float* __restrict__ gw, bf16_t* __restrict__ mix) {
  const int tid = tidx(), lane = tid & 63, wv = tid >> 6;
  for (int tok = blockIdx.x * 4 + wv; tok < TOK; tok += gridDim.x * 4) {
    float x[16];
#pragma unroll
    for (int i = 0; i < 4; ++i) { const float4 v = *(const float4*)(ogla + (size_t)tok * 1024 + lane * 16 + i * 4); x[4 * i] = v.x; x[4 * i + 1] = v.y; x[4 * i + 2] = v.z; x[4 * i + 3] = v.w; }
    float ss = 0.f;
#pragma unroll
    for (int e = 0; e < 16; ++e) ss += x[e] * x[e];
    ss += __shfl_xor(ss, 1); ss += __shfl_xor(ss, 2); ss += __shfl_xor(ss, 4);
    const float r = rsqrtf(ss * (1.f / 128.f) + 1e-6f);
    const uint4 g0 = *(const uint4*)(z + (size_t)tok * ABP + ZG + lane * 16);
    const uint4 g1 = *(const uint4*)(z + (size_t)tok * ABP + ZG + lane * 16 + 8);
    const float gg[16] = {lo2f(g0.x), hi2f(g0.x), lo2f(g0.y), hi2f(g0.y), lo2f(g0.z), hi2f(g0.z), lo2f(g0.w), hi2f(g0.w),
                          lo2f(g1.x), hi2f(g1.x), lo2f(g1.y), hi2f(g1.y), lo2f(g1.z), hi2f(g1.z), lo2f(g1.w), hi2f(g1.w)};
    const float* w = gw + (lane & 7) * 16;
    float y[16];
#pragma unroll
    for (int e = 0; e < 16; ++e) y[e] = x[e] * r * w[e] * (gg[e] * sigmoidf_(gg[e]));
    uint4 o0, o1;
    o0.x = pack2(y[0], y[1]); o0.y = pack2(y[2], y[3]); o0.z = pack2(y[4], y[5]); o0.w = pack2(y[6], y[7]);
    o1.x = pack2(y[8], y[9]); o1.y = pack2(y[10], y[11]); o1.z = pack2(y[12], y[13]); o1.w = pack2(y[14], y[15]);
    *(uint4*)(mix + (size_t)tok * DM + lane * 16) = o0;
    *(uint4*)(mix + (size_t)tok * DM + lane * 16 + 8) = o1;
  }
}

DI int koff(int row, int chunk) { return row * 256 + ((chunk ^ (row & 15)) << 4); }
DI int k2off(int row, int chunk) { return row * 128 + ((chunk ^ ((row >> 1) & 7)) << 4); }
DI int voff(int row, int chunk) { return row * 256 + ((((chunk >> 1) ^ (row & 7)) << 5) | ((chunk & 1) << 4)); }

DI void ldg_tile(int tid, const bf16_t* __restrict__ g, int ld, u32x4 (&r)[4]) {
#pragma unroll
  for (int i = 0; i < 4; ++i) { const int idx = tid + 256 * i, row = idx >> 4, ch = idx & 15; r[i] = *(const u32x4*)(g + (size_t)row * ld + ch * 8); }
}
DI void sts_tile_k(int tid, const u32x4 (&r)[4], char* dst) {
#pragma unroll
  for (int i = 0; i < 4; ++i) { const int idx = tid + 256 * i, row = idx >> 4, ch = idx & 15; *(u32x4*)(dst + koff(row, ch)) = r[i]; }
}
DI void sts_tile_v(int tid, const u32x4 (&r)[4], char* dst) {
#pragma unroll
  for (int i = 0; i < 4; ++i) { const int idx = tid + 256 * i, row = idx >> 4, ch = idx & 15; *(u32x4*)(dst + voff(row, ch)) = r[i]; }
}
DI void ldg_tile_k2(int tid, const bf16_t* __restrict__ g, int ld, u32x4 (&r)[2]) {
#pragma unroll
  for (int i = 0; i < 2; ++i) { const int idx = tid + 256 * i, row = idx >> 3, ch = idx & 7; r[i] = *(const u32x4*)(g + (size_t)row * ld + ch * 8); }
}
DI void sts_tile_k2(int tid, const u32x4 (&r)[2], char* dst) {
#pragma unroll
  for (int i = 0; i < 2; ++i) { const int idx = tid + 256 * i, row = idx >> 3, ch = idx & 7; *(u32x4*)(dst + k2off(row, ch)) = r[i]; }
}
DI void load_tile_k(int tid, const bf16_t* __restrict__ g, int ld, char* dst) { u32x4 r[4]; ldg_tile(tid, g, ld, r); sts_tile_k(tid, r, dst); }
DI void load_tile_v(int tid, const bf16_t* __restrict__ g, int ld, char* dst) { u32x4 r[4]; ldg_tile(tid, g, ld, r); sts_tile_v(tid, r, dst); }
template <int NKS, int QS>
DI void qk_tile(const char* Ks, const bf16x8 (&qf)[QS][6], int ks0, f32x4 (&s)[4][QS], int lane) {
#pragma unroll
  for (int ks = 0; ks < NKS; ++ks)
#pragma unroll
    for (int kt = 0; kt < 4; ++kt) {
      const bf16x8 kf = *(const bf16x8*)(Ks + koff(kt * 16 + (lane & 15), ks * 4 + (lane >> 4)));
#pragma unroll
      for (int qs = 0; qs < QS; ++qs) s[kt][qs] = __builtin_amdgcn_mfma_f32_16x16x32_bf16(kf, qf[qs][ks0 + ks], s[kt][qs], 0, 0, 0);
    }
}
template <int QS>
DI void qk_tile2(const char* K2s, const bf16x8 (&qf)[QS][6], f32x4 (&s)[4][QS], int lane) {
#pragma unroll
  for (int ks = 0; ks < 2; ++ks)
#pragma unroll
    for (int kt = 0; kt < 4; ++kt) {
      const bf16x8 kf = *(const bf16x8*)(K2s + k2off(kt * 16 + (lane & 15), ks * 4 + (lane >> 4)));
#pragma unroll
      for (int qs = 0; qs < QS; ++qs) s[kt][qs] = __builtin_amdgcn_mfma_f32_16x16x32_bf16(kf, qf[qs][4 + ks], s[kt][qs], 0, 0, 0);
    }
}
template <int QS>
DI void pv_tile(const char* Vs, const f32x4 (&s)[4][QS], f32x4 (&o)[QS][8], int lane) {
  const int g = lane >> 4, i = lane & 15;
#pragma unroll
  for (int c = 0; c < 2; ++c) {
    bf16x8 pf[QS];
#pragma unroll
    for (int qs = 0; qs < QS; ++qs) {
      union { uint4 u; bf16x8 v; } cv;
      cv.u.x = pack2(s[2 * c][qs][0], s[2 * c][qs][1]); cv.u.y = pack2(s[2 * c][qs][2], s[2 * c][qs][3]);
      cv.u.z = pack2(s[2 * c + 1][qs][0], s[2 * c + 1][qs][1]); cv.u.w = pack2(s[2 * c + 1][qs][2], s[2 * c + 1][qs][3]);
      pf[qs] = cv.v;
    }
    const int r1 = 32 * c + 4 * g + (i >> 2), r2 = r1 + 16;
#pragma unroll
    for (int dt = 0; dt < 8; ++dt) {
      const s16x4 lo = __builtin_amdgcn_ds_read_tr16_b64_v4i16(LDSP(s16x4, Vs + r1 * 256 + ((dt ^ (r1 & 7)) << 5) + 8 * (i & 3)));
      const s16x4 hi = __builtin_amdgcn_ds_read_tr16_b64_v4i16(LDSP(s16x4, Vs + r2 * 256 + ((dt ^ (r2 & 7)) << 5) + 8 * (i & 3)));
      bf16x8 vf; vf[0] = lo[0]; vf[1] = lo[1]; vf[2] = lo[2]; vf[3] = lo[3]; vf[4] = hi[0]; vf[5] = hi[1]; vf[6] = hi[2]; vf[7] = hi[3];
#pragma unroll
      for (int qs = 0; qs < QS; ++qs) o[qs][dt] = __builtin_amdgcn_mfma_f32_16x16x32_bf16(vf, pf[qs], o[qs][dt], 0, 0, 0);
    }
  }
}

enum { AM_MLA = 0, AM_WIN = 1, AM_SEL = 2 };
template <int MODE, int QS>
DI void softmax_tile(f32x4 (&s)[4][QS], f32x4 (&o)[QS][8], float (&m)[QS], float (&l)[QS], const int (&qi)[QS], const unsigned (&qmask)[QS],
                     int kbase, int tilebit, float sc, int lane, bool interior) {
  const int g = lane >> 4;
#pragma unroll
  for (int qs = 0; qs < QS; ++qs) {
    float mx = -1e30f;
    if (interior) {
      float sce = sc, bias = 0.f;
      if (MODE == AM_SEL) { const bool on = (qmask[qs] >> tilebit) & 1u; sce = on ? sc : 0.f; bias = on ? 0.f : -1e30f; }
#pragma unroll
      for (int kt = 0; kt < 4; ++kt)
#pragma unroll
        for (int r = 0; r < 4; ++r) { const float x = fmaf(s[kt][qs][r], sce, bias); s[kt][qs][r] = x; mx = fmaxf(mx, x); }
    } else {
#pragma unroll
      for (int kt = 0; kt < 4; ++kt)
#pragma unroll
        for (int r = 0; r < 4; ++r) {
          const int kj = kbase + kt * 16 + 4 * g + r;
          bool v = kj <= qi[qs];
          if (MODE == AM_WIN) v = v && (kj > qi[qs] - 512);
          if (MODE == AM_SEL) v = v && ((qmask[qs] >> tilebit) & 1u);
          const float x = v ? s[kt][qs][r] * sc : -1e30f;
          s[kt][qs][r] = x;
          mx = fmaxf(mx, x);
        }
    }
    mx = fmaxf(mx, __shfl_xor(mx, 16)); mx = fmaxf(mx, __shfl_xor(mx, 32));
    const float mn = fmaxf(m[qs], mx);
    const float alpha = __builtin_amdgcn_exp2f(m[qs] - mn);
    m[qs] = mn;
    const float mnc = fmaxf(mn, -1e20f);
    float ps = 0.f;
#pragma unroll
    for (int kt = 0; kt < 4; ++kt)
#pragma unroll
      for (int r = 0; r < 4; ++r) { const float p = __builtin_amdgcn_exp2f(s[kt][qs][r] - mnc); s[kt][qs][r] = p; ps += p; }
    l[qs] = l[qs] * alpha + ps;
    if (!__all(alpha == 1.f)) {
#pragma unroll
      for (int dt = 0; dt < 8; ++dt) o[qs][dt] *= alpha;
    }
  }
}

template <int QS>
DI void mla_attn_item(int item, const bf16_t* __restrict__ q, const bf16_t* __restrict__ kv, const bf16_t* __restrict__ krope,
                              const int* __restrict__ pos, bf16_t* __restrict__ mix, char* smem) {
  const int tid = tidx(), lane = tid & 63, wave = tid >> 6, g = lane >> 4, i16 = lane & 15;
  const int qt = (NQT - 1) - (item >> 5), bh = item & 31, b = bh >> 3, h = bh & 7;
  const int q0 = qt * QB;
  const size_t tb = (size_t)b * SEQ;
  char* Ks = smem; char* Vs = smem + 16384; char* K2s = smem + 32768;
  bf16x8 qf[QS][6]; int qi[QS]; unsigned qm[QS] = {};
#pragma unroll
  for (int qs = 0; qs < QS; ++qs) {
    qi[qs] = q0 + wave * (16 * QS) + qs * 16 + i16;
    const bf16_t* qp = q + (tb + qi[qs]) * 1536 + h * 192;
#pragma unroll
    for (int ks = 0; ks < 6; ++ks) qf[qs][ks] = *(const bf16x8*)(qp + ks * 32 + g * 8);
    const int p = pos[tb + qi[qs]];
#pragma unroll
    for (int j = 0; j < 8; ++j) {
      float c, s; rope_cs(p, 8 * g + j, 13.287712379549449f / 32.f, c, s);
      const float x1 = bf2f((bf16_t)qf[qs][4][j]), x2 = bf2f((bf16_t)qf[qs][5][j]);
      qf[qs][4][j] = (short)f2bf(x1 * c - x2 * s);
      qf[qs][5][j] = (short)f2bf(x2 * c + x1 * s);
    }
  }
  f32x4 o[QS][8];
#pragma unroll
  for (int qs = 0; qs < QS; ++qs)
#pragma unroll
    for (int dt = 0; dt < 8; ++dt) o[qs][dt] = (f32x4){0.f, 0.f, 0.f, 0.f};
  float m[QS], l[QS];
#pragma unroll
  for (int qs = 0; qs < QS; ++qs) { m[qs] = -1e30f; l[qs] = 0.f; }
  const float sc = 0.07216878364870322f * 1.4426950408889634f;
  const int ntile = (qt + 1) * QS;
#pragma unroll 1
  for (int j = 0; j < ntile; ++j) {
    __syncthreads();
    load_tile_k(tid, kv + (tb + j * 64) * 2048 + h * 256, 2048, Ks);
    load_tile_v(tid, kv + (tb + j * 64) * 2048 + h * 256 + 128, 2048, Vs);
    { u32x4 r2[2]; ldg_tile_k2(tid, krope + (tb + j * 64) * 64, 64, r2); sts_tile_k2(tid, r2, K2s); }
    __syncthreads();
    f32x4 s[4][QS];
#pragma unroll
    for (int kt = 0; kt < 4; ++kt)
#pragma unroll
      for (int qs = 0; qs < QS; ++qs) s[kt][qs] = (f32x4){0.f, 0.f, 0.f, 0.f};
    qk_tile<4, QS>(Ks, qf, 0, s, lane);
    qk_tile2<QS>(K2s, qf, s, lane);
    softmax_tile<AM_MLA, QS>(s, o, m, l, qi, qm, j * 64, 0, sc, lane, j * 64 + 63 <= q0);
    pv_tile<QS>(Vs, s, o, lane);
  }
#pragma unroll
  for (int qs = 0; qs < QS; ++qs) {
    float lt = l[qs]; lt += __shfl_xor(lt, 16); lt += __shfl_xor(lt, 32);
    const float inv = lt > 0.f ? 1.f / lt : 0.f;
    bf16_t* op = mix + (tb + qi[qs]) * DM + 1024 + h * 128;
#pragma unroll
    for (int dt = 0; dt < 8; ++dt) {
      uint2 w; w.x = pack2(o[qs][dt][0] * inv, o[qs][dt][1] * inv); w.y = pack2(o[qs][dt][2] * inv, o[qs][dt][3] * inv);
      *(uint2*)(op + dt * 16 + 4 * g) = w;
    }
  }
}

DI void gla_pass1(int item, const bf16_t* __restrict__ z, const float* __restrict__ w_up, const float* __restrict__ b_alpha,
                  float* __restrict__ Ubuf, float* __restrict__ Ebuf, char* smem) {
  const int tid = tidx(), lane = tid & 63, wave = tid >> 6, g = lane >> 4;
  const int b = item >> 8, h = (item >> 5) & 7, n = item & 31;
  float* kiT = (float*)smem;
  char* Vs = (char*)(kiT + 64 * 68);
  float* alr = (float*)(Vs + 16384);
  float* seg = alr + 64 * 16;
  float* Ed = seg + 256;
  float wu[16];
#pragma unroll
  for (int r = 0; r < 16; ++r) wu[r] = w_up[r * 512 + h * 64 + (tid & 63)];
  const float ba = b_alpha[h * 64 + (tid & 63)];
  const size_t tok0 = (size_t)b * SEQ + n * 64;
  __syncthreads();
  load_tile_v(tid, z + tok0 * ABP + ZV + h * 128, ABP, Vs);
  gla_prologue<false>(tid, z, tok0, h, wu, ba, nullptr, kiT, alr, seg, Ed);
  const int dq = wave * 16 + (lane & 15);
  f32x4 sk[4][1], o[1][8];
#pragma unroll
  for (int kt = 0; kt < 4; ++kt) sk[kt][0] = *(const f32x4*)(kiT + dq * 68 + kt * 16 + 4 * g);
#pragma unroll
  for (int dt = 0; dt < 8; ++dt) o[0][dt] = zero4();
  pv_tile<1>(Vs, sk, o, lane);
  float* up = Ubuf + ((size_t)item * 64 + dq) * 128 + 4 * g;
#pragma unroll
  for (int dt = 0; dt < 8; ++dt) *(f32x4*)(up + dt * 16) = o[0][dt];
  if (g == 0) Ebuf[(size_t)item * 64 + dq] = Ed[dq];
}

DI void gla_pass3(int item, const bf16_t* __restrict__ z, const float* __restrict__ w_up, const float* __restrict__ b_alpha,
                  const float* __restrict__ Sbuf, const float* __restrict__ gw, bf16_t* __restrict__ mix, char* smem) {
  const int tid = tidx(), lane = tid & 63, wave = tid >> 6, g = lane >> 4;
  const int b = item >> 8, h = (item >> 5) & 7, n = item & 31;
  float* qdT = (float*)smem;
  float* kiT = qdT + 64 * 68;
  char* Ss = (char*)(kiT + 64 * 68);
  float* alr = (float*)(Ss + 16384);
  float* seg = alr + 64 * 16;
  float* Ed = seg + 256;
  char* Vs = smem;
  float wu[16];
#pragma unroll
  for (int r = 0; r < 16; ++r) wu[r] = w_up[r * 512 + h * 64 + (tid & 63)];
  const float ba = b_alpha[h * 64 + (tid & 63)];
  const size_t tok0 = (size_t)b * SEQ + n * 64;
  __syncthreads();
  gla_prologue<true>(tid, z, tok0, h, wu, ba, qdT, kiT, alr, seg, Ed);
  const int iq = wave * 16 + (lane & 15);
  f32x4 sq[4][1];
  {
    const int ti = tid >> 4, tj = tid & 15;
    float a4[4][4];
#pragma unroll
    for (int i = 0; i < 4; ++i)
#pragma unroll
      for (int j = 0; j < 4; ++j) a4[i][j] = 0.f;
    if (tj <= ti) {
#pragma unroll 4
      for (int d = 0; d < 64; ++d) {
        const f32x4 qv = *(const f32x4*)(qdT + d * 68 + ti * 4);
        const f32x4 kv = *(const f32x4*)(kiT + d * 68 + tj * 4);
#pragma unroll
        for (int i = 0; i < 4; ++i)
#pragma unroll
          for (int j = 0; j < 4; ++j) a4[i][j] += qv[i] * kv[j];
      }
    }
#pragma unroll
    for (int kt = 0; kt < 4; ++kt)
#pragma unroll
      for (int r = 0; r < 4; ++r) sq[kt][0][r] = qdT[(kt * 16 + 4 * g + r) * 68 + iq];
    __syncthreads();
#pragma unroll
    for (int i = 0; i < 4; ++i) {
      f32x4 o;
#pragma unroll
      for (int j = 0; j < 4; ++j) o[j] = (tj * 4 + j <= ti * 4 + i) ? a4[i][j] : 0.f;
      *(f32x4*)(kiT + (ti * 4 + i) * 68 + tj * 4) = o;
    }
  }
  load_tile_v(tid, z + tok0 * ABP + ZV + h * 128, ABP, Vs);
  {
    const float* Sg = Sbuf + (size_t)item * 64 * 128;
#pragma unroll
    for (int i = 0; i < 4; ++i) {
      const int idx = tid + 256 * i, row = idx >> 4, ch = idx & 15;
      const f32x4 x0 = *(const f32x4*)(Sg + row * 128 + ch * 8), x1 = *(const f32x4*)(Sg + row * 128 + ch * 8 + 4);
      u32x4 w; w[0] = pack2(x0[0], x0[1]); w[1] = pack2(x0[2], x0[3]); w[2] = pack2(x1[0], x1[1]); w[3] = pack2(x1[2], x1[3]);
      *(u32x4*)(Ss + voff(row, ch)) = w;
    }
  }
  __syncthreads();
  f32x4 o[1][8];
#pragma unroll
  for (int dt = 0; dt < 8; ++dt) o[0][dt] = (f32x4){0.f, 0.f, 0.f, 0.f};
  {
    f32x4 sa[4][1];
#pragma unroll
    for (int kt = 0; kt < 4; ++kt) sa[kt][0] = *(const f32x4*)(kiT + iq * 68 + kt * 16 + 4 * g);
    pv_tile<1>(Vs, sa, o, lane);
    pv_tile<1>(Ss, sq, o, lane);
  }
  {
    float ssq = 0.f;
#pragma unroll
    for (int dt = 0; dt < 8; ++dt) ssq += (o[0][dt][0] * o[0][dt][0] + o[0][dt][1] * o[0][dt][1]) + (o[0][dt][2] * o[0][dt][2] + o[0][dt][3] * o[0][dt][3]);
    ssq += __shfl_xor(ssq, 16); ssq += __shfl_xor(ssq, 32);
    const float r = rsqrtf(ssq * (1.f / 128.f) + 1e-6f);
#pragma unroll
    for (int dt = 0; dt < 8; ++dt) {
      const int dv = dt * 16 + 4 * g, col = h * 128 + dv;
      const u32x2 gq = *(const u32x2*)(z + (tok0 + iq) * ABP + ZG + col);
      const float gg[4] = {lo2f(gq[0]), hi2f(gq[0]), lo2f(gq[1]), hi2f(gq[1])};
      const f32x4 w = *(const f32x4*)(gw + dv);
      float y[4];
#pragma unroll
      for (int e = 0; e < 4; ++e) y[e] = o[0][dt][e] * r * w[e] * (gg[e] * sigmoidf_(gg[e]));
      u32x2 ov; ov[0] = pack2(y[0], y[1]); ov[1] = pack2(y[2], y[3]);
      *(u32x2*)(mix + (tok0 + iq) * DM + col) = ov;
    }
  }
}

DI void rope4(bf16_t* p1, const float (&c)[4], const float (&sn)[4], float (&y1)[4], float (&y2)[4]) {
  const u32x2 a = *(const u32x2*)p1, b = *(const u32x2*)(p1 + 64);
  const float x1[4] = {lo2f(a[0]), hi2f(a[0]), lo2f(a[1]), hi2f(a[1])}, x2[4] = {lo2f(b[0]), hi2f(b[0]), lo2f(b[1]), hi2f(b[1])};
#pragma unroll
  for (int e = 0; e < 4; ++e) { y1[e] = x1[e] * c[e] - x2[e] * sn[e]; y2[e] = x2[e] * c[e] + x1[e] * sn[e]; }
}
DI void st4bf(bf16_t* p, const float (&y)[4]) { u32x2 o; o[0] = pack2(y[0], y[1]); o[1] = pack2(y[2], y[3]); *(u32x2*)p = o; }
DI void nsa_prep(bf16_t* __restrict__ z, const int* __restrict__ pos, const float* __restrict__ cpos,
                 bf16_t* __restrict__ aflk, bf16_t* __restrict__ aflv, const float* __restrict__ slab, const float* __restrict__ rowss) {
  const int tid = tidx(), lane = tid & 63, wv = tid >> 6;
  for (int idx = blockIdx.x * 256 + tid; idx < 2 * 16 * 512; idx += gridDim.x * 256) {
    const int which = idx >> 13, r = idx & 8191, bg = r >> 9, ch = r & 511;
    *(u32x4*)((which ? aflv : aflk) + ((size_t)bg * 128 + 127) * 4096 + ch * 8) = (u32x4){0u, 0u, 0u, 0u};
  }
  const int hq = lane >> 4, d0 = (lane & 15) * 4;
  for (int tok = blockIdx.x * 4 + wv; tok < TOK; tok += gridDim.x * 4) {
    bf16_t* zr = z + (size_t)tok * NSP;
    const int b = tok >> 11, s = tok & 2047;
    if (lane < 48) zr[NGL + lane] = f2bf(slab_sum(slab, tok, lane) * row_rsc(rowss, tok));
    float c[4], sn[4];
    const int ps = pos[tok];
#pragma unroll
    for (int e = 0; e < 4; ++e) rope_cs(ps, d0 + e, 13.287712379549449f / 64.f, c[e], sn[e]);
    float y1[4], y2[4];
#pragma unroll
    for (int it = 0; it < 4; ++it) {
      bf16_t* p = zr + NQ + (it * 4 + hq) * 128 + d0;
      rope4(p, c, sn, y1, y2); st4bf(p, y1); st4bf(p + 64, y2);
    }
    { bf16_t* p = zr + NKS + hq * 128 + d0; rope4(p, c, sn, y1, y2); st4bf(p, y1); st4bf(p + 64, y2); }
    { bf16_t* p = zr + NKW + hq * 128 + d0; rope4(p, c, sn, y1, y2); st4bf(p, y1); st4bf(p + 64, y2); }
    rope4(zr + NKC + hq * 128 + d0, c, sn, y1, y2);
    float v1[4], v2[4];
    {
      const u32x2 a = *(const u32x2*)(zr + NVC + hq * 128 + d0), bq = *(const u32x2*)(zr + NVC + hq * 128 + 64 + d0);
      v1[0] = lo2f(a[0]); v1[1] = hi2f(a[0]); v1[2] = lo2f(a[1]); v1[3] = hi2f(a[1]);
      v2[0] = lo2f(bq[0]); v2[1] = hi2f(bq[0]); v2[2] = lo2f(bq[1]); v2[3] = hi2f(bq[1]);
    }
    const int n1 = s >> 4, l1 = s & 15;
    const size_t rb = (size_t)(b * 4 + hq) * 128;
#pragma unroll
    for (int w = 0; w < 2; ++w) {
      const int n = n1 - w, l = l1 + 16 * w;
      if (n >= 0 && n <= 126) {
        const size_t o = (rb + n) * 4096 + l * 128 + d0;
        const f32x4 pk1 = *(const f32x4*)(cpos + l * 128 + d0), pk2 = *(const f32x4*)(cpos + l * 128 + 64 + d0);
        const f32x4 pv1 = *(const f32x4*)(cpos + 4096 + l * 128 + d0), pv2 = *(const f32x4*)(cpos + 4096 + l * 128 + 64 + d0);
        const float a1[4] = {y1[0] + pk1[0], y1[1] + pk1[1], y1[2] + pk1[2], y1[3] + pk1[3]};
        const float a2[4] = {y2[0] + pk2[0], y2[1] + pk2[1], y2[2] + pk2[2], y2[3] + pk2[3]};
        const float b1[4] = {v1[0] + pv1[0], v1[1] + pv1[1], v1[2] + pv1[2], v1[3] + pv1[3]};
        const float b2[4] = {v2[0] + pv2[0], v2[1] + pv2[1], v2[2] + pv2[2], v2[3] + pv2[3]};
        st4bf(aflk + o, a1); st4bf(aflk + o + 64, a2);
        st4bf(aflv + o, b1); st4bf(aflv + o + 64, b2);
      }
    }
  }
}

template <int QS>
DI void load_q128(const bf16_t* __restrict__ z, size_t tb, int hh, int q0, int wave, int lane, bf16x8 (&qf)[QS][6], int (&qi)[QS]) {
#pragma unroll
  for (int qs = 0; qs < QS; ++qs) {
    qi[qs] = q0 + wave * (16 * QS) + qs * 16 + (lane & 15);
    const bf16_t* qp = z + (tb + qi[qs]) * NSP + NQ + hh * 128;
#pragma unroll
    for (int ks = 0; ks < 4; ++ks) qf[qs][ks] = *(const bf16x8*)(qp + ks * 32 + (lane >> 4) * 8);
    qf[qs][4] = qf[qs][0]; qf[qs][5] = qf[qs][0];
  }
}
DI float nsa_gate(const bf16_t* __restrict__ z, const float* __restrict__ bg, size_t tokrow, int hh, int c) {
  return sigmoidf_(bf2f(z[tokrow * NSP + NGL + hh * 3 + c]) + bg[hh * 3 + c]);
}

template <int QS>
DI void nsa_cmpwin_item(int item, const bf16_t* __restrict__ z, const bf16_t* __restrict__ kcmp, const bf16_t* __restrict__ vcmp,
                                const float* __restrict__ bgate, float* __restrict__ P, float* __restrict__ part, char* smem) {
  const int tid = tidx(), lane = tid & 63, wave = tid >> 6, g = lane >> 4;
  const int qt = item % NQT, hh = (item / NQT) & 15, b = item / (NQT * 16), grp = hh >> 2;
  const int q0 = qt * QB;
  const size_t tb = (size_t)b * SEQ;
  bf16x8 qf[QS][6]; int qi[QS]; unsigned qm[QS] = {};
  load_q128<QS>(z, tb, hh, q0, wave, lane, qf, qi);
  const float sc = 0.08838834764831845f * 1.4426950408889634f;
  f32x4 o[QS][8];
  {
    __syncthreads();
    const bf16_t* kc = kcmp + (size_t)(b * 4 + grp) * 128 * 128;
    const bf16_t* vc = vcmp + (size_t)(b * 4 + grp) * 128 * 128;
    load_tile_k(tid, kc, 128, smem); load_tile_k(tid, kc + 64 * 128, 128, smem + 16384);
    load_tile_v(tid, vc, 128, smem + 32768); load_tile_v(tid, vc + 64 * 128, 128, smem + 49152);
    __syncthreads();
    f32x4 s0[4][QS], s1[4][QS];
#pragma unroll
    for (int kt = 0; kt < 4; ++kt)
#pragma unroll
      for (int qs = 0; qs < QS; ++qs) { s0[kt][qs] = (f32x4){0.f, 0.f, 0.f, 0.f}; s1[kt][qs] = (f32x4){0.f, 0.f, 0.f, 0.f}; }
    qk_tile<4, QS>(smem, qf, 0, s0, lane);
    qk_tile<4, QS>(smem + 16384, qf, 0, s1, lane);
#pragma unroll
    for (int qs = 0; qs < QS; ++qs) {
      float mx = -1e30f;
#pragma unroll
      for (int kt = 0; kt < 4; ++kt)
#pragma unroll
        for (int r = 0; r < 4; ++r) {
          const int n = kt * 16 + 4 * g + r;
          const float x0 = (16 * n + 31 <= qi[qs]) ? s0[kt][qs][r] * sc : -1e30f;
          const float x1 = (16 * (n + 64) + 31 <= qi[qs]) ? s1[kt][qs][r] * sc : -1e30f;
          s0[kt][qs][r] = x0; s1[kt][qs][r] = x1; mx = fmaxf(mx, fmaxf(x0, x1));
        }
      mx = fmaxf(mx, __shfl_xor(mx, 16)); mx = fmaxf(mx, __shfl_xor(mx, 32));
      float ps = 0.f;
#pragma unroll
      for (int kt = 0; kt < 4; ++kt)
#pragma unroll
        for (int r = 0; r < 4; ++r) {
          const float p0 = s0[kt][qs][r] > -1e29f ? exp2f(s0[kt][qs][r] - mx) : 0.f;
          const float p1 = s1[kt][qs][r] > -1e29f ? exp2f(s1[kt][qs][r] - mx) : 0.f;
          s0[kt][qs][r] = p0; s1[kt][qs][r] = p1; ps += p0 + p1;
        }
      ps += __shfl_xor(ps, 16); ps += __shfl_xor(ps, 32);
      const float inv = ps > 0.f ? 1.f / ps : 0.f;
      float* pp = P + (((size_t)b * 16 + hh) * SEQ + qi[qs]) * 128;
#pragma unroll
      for (int kt = 0; kt < 4; ++kt) {
        s0[kt][qs] *= inv; s1[kt][qs] *= inv;
        *(f32x4*)(pp + kt * 16 + 4 * g) = s0[kt][qs];
        *(f32x4*)(pp + 64 + kt * 16 + 4 * g) = s1[kt][qs];
      }
    }
#pragma unroll
    for (int qs = 0; qs < QS; ++qs)
#pragma unroll
      for (int dt = 0; dt < 8; ++dt) o[qs][dt] = (f32x4){0.f, 0.f, 0.f, 0.f};
    pv_tile<QS>(smem + 32768, s0, o, lane);
    pv_tile<QS>(smem + 49152, s1, o, lane);
#pragma unroll
    for (int qs = 0; qs < QS; ++qs) {
      const float g0 = nsa_gate(z, bgate, tb + qi[qs], hh, 0);
      float* op = part + (tb + qi[qs]) * DM + hh * 128;
#pragma unroll
      for (int dt = 0; dt < 8; ++dt) *(f32x4*)(op + dt * 16 + 4 * g) = o[qs][dt] * g0;
    }
  }
  {
    char* Ks = smem; char* Vs = smem + 16384;
#pragma unroll
    for (int qs = 0; qs < QS; ++qs)
#pragma unroll
      for (int dt = 0; dt < 8; ++dt) o[qs][dt] = (f32x4){0.f, 0.f, 0.f, 0.f};
    float m[QS], l[QS];
#pragma unroll
  for (int qs = 0; qs < QS; ++qs) { m[qs] = -1e30f; l[qs] = 0.f; }
    const int j0 = (qt * QS - 8) > 0 ? (qt * QS - 8) : 0, j1 = qt * QS + QS - 1;
#pragma unroll 1
    for (int j = j0; j <= j1; ++j) {
      __syncthreads();
      load_tile_k(tid, z + (tb + j * 64) * NSP + NKW + grp * 128, NSP, Ks);
      load_tile_v(tid, z + (tb + j * 64) * NSP + NVW + grp * 128, NSP, Vs);
      __syncthreads();
      f32x4 s[4][QS];
#pragma unroll
      for (int kt = 0; kt < 4; ++kt)
#pragma unroll
        for (int qs = 0; qs < QS; ++qs) s[kt][qs] = (f32x4){0.f, 0.f, 0.f, 0.f};
      qk_tile<4, QS>(Ks, qf, 0, s, lane);
      softmax_tile<AM_WIN, QS>(s, o, m, l, qi, qm, j * 64, 0, sc, lane, (j * 64 + 63 <= q0) && (j * 64 > q0 + QB - 1 - 512));
      pv_tile<QS>(Vs, s, o, lane);
    }
#pragma unroll
    for (int qs = 0; qs < QS; ++qs) {
      float lt = l[qs]; lt += __shfl_xor(lt, 16); lt += __shfl_xor(lt, 32);
      const float inv = (lt > 0.f ? 1.f / lt : 0.f) * nsa_gate(z, bgate, tb + qi[qs], hh, 2);
      float* op = part + (tb + qi[qs]) * DM + hh * 128;
#pragma unroll
      for (int dt = 0; dt < 8; ++dt) { f32x4 pv = *(f32x4*)(op + dt * 16 + 4 * g); pv += o[qs][dt] * inv; *(f32x4*)(op + dt * 16 + 4 * g) = pv; }
    }
  }
}

DI void nsa_select(const float* __restrict__ P, unsigned* __restrict__ sel) {
  const int tid = tidx(), lane = tid & 63, wv = tid >> 6, m = lane & 31, half = lane >> 5;
  for (int base = (blockIdx.x * 4 + wv) * 2; base < 16 * SEQ; base += gridDim.x * 8) {
    const int idx = base + half;
    const int bg = idx >> 11, s = idx & 2047, b = bg >> 2, grp = bg & 3;
    float imp = 0.f, lastv = 0.f;
#pragma unroll
    for (int j = 0; j < 4; ++j) {
      const f32x4 pv = *(const f32x4*)(P + (((size_t)b * 16 + grp * 4 + j) * SEQ + s) * 128 + 4 * m);
      imp += (pv[0] + pv[1]) + (pv[2] + pv[3]);
      lastv += pv[3];
    }
    {
      const float prevl = __shfl(lastv, half * 32 + ((m + 31) & 31));
      if (m >= 1) imp += prevl;
    }
    const int cur = s >> 6;
    const bool cand = (m >= 1) && (m <= cur - 2);
    int rank = 0;
    for (int mm = 0; mm < 32; ++mm) {
      const float v = __shfl(imp, half * 32 + mm);
      const bool c2 = (mm >= 1) && (mm <= cur - 2);
      if (c2 && (v > imp || (v == imp && mm < m))) ++rank;
    }
    bool selb;
    if (cur <= 15) selb = (m <= cur);
    else selb = (m == 0) || (m == cur) || (m == cur - 1) || (cand && rank < 13);
    const unsigned long long bal = __ballot(selb);
    const unsigned mk = half ? (unsigned)(bal >> 32) : (unsigned)(bal & 0xffffffffull);
    if (m == 0) sel[idx] = mk;
  }
}

template <int QS>
DI void nsa_sel_item(int item, const bf16_t* __restrict__ z, const unsigned* __restrict__ sel, const float* __restrict__ bgate,
                             const float* __restrict__ part, bf16_t* __restrict__ mix, char* smem) {
  const int tid = tidx(), lane = tid & 63, wave = tid >> 6, g = lane >> 4;
  const int qt = (NQT - 1) - (item >> 6), bh = item & 63, b = bh >> 4, hh = bh & 15, grp = hh >> 2;
  const int q0 = qt * QB;
  const size_t tb = (size_t)b * SEQ;
  bf16x8 qf[QS][6]; int qi[QS]; unsigned qm[QS];
  load_q128<QS>(z, tb, hh, q0, wave, lane, qf, qi);
  unsigned um = 0u;
#pragma unroll
  for (int qs = 0; qs < QS; ++qs) { qm[qs] = sel[(size_t)(b * 4 + grp) * SEQ + qi[qs]]; um |= qm[qs]; }
#pragma unroll
  for (int o2 = 1; o2 < 16; o2 <<= 1) um |= __shfl_xor(um, o2);
  unsigned* ush = (unsigned*)(smem + 40960);
  __syncthreads();
  if (lane == 0) ush[wave] = um;
  __syncthreads();
  um = ush[0] | ush[1] | ush[2] | ush[3];
  const float sc = 0.08838834764831845f * 1.4426950408889634f;
  char* Ks = smem; char* Vs = smem + 16384;
  f32x4 o[QS][8];
#pragma unroll
  for (int qs = 0; qs < QS; ++qs)
#pragma unroll
    for (int dt = 0; dt < 8; ++dt) o[qs][dt] = (f32x4){0.f, 0.f, 0.f, 0.f};
  float m[QS], l[QS];
#pragma unroll
  for (int qs = 0; qs < QS; ++qs) { m[qs] = -1e30f; l[qs] = 0.f; }
  const int j1 = qt * QS + QS - 1;
  unsigned rem = um & ((j1 >= 31) ? 0xffffffffu : ((2u << j1) - 1u));
#pragma unroll 1
  while (rem) {
    const int j = __builtin_ctz(rem);
    rem &= rem - 1u;
    __syncthreads();
    load_tile_k(tid, z + (tb + j * 64) * NSP + NKS + grp * 128, NSP, Ks);
    load_tile_v(tid, z + (tb + j * 64) * NSP + NVS + grp * 128, NSP, Vs);
    __syncthreads();
    f32x4 s[4][QS];
#pragma unroll
    for (int kt = 0; kt < 4; ++kt)
#pragma unroll
      for (int qs = 0; qs < QS; ++qs) s[kt][qs] = (f32x4){0.f, 0.f, 0.f, 0.f};
    qk_tile<4, QS>(Ks, qf, 0, s, lane);
    softmax_tile<AM_SEL, QS>(s, o, m, l, qi, qm, j * 64, j, sc, lane, j * 64 + 63 <= q0);
    pv_tile<QS>(Vs, s, o, lane);
  }
#pragma unroll
  for (int qs = 0; qs < QS; ++qs) {
    float lt = l[qs]; lt += __shfl_xor(lt, 16); lt += __shfl_xor(lt, 32);
    const float inv = (lt > 0.f ? 1.f / lt : 0.f) * nsa_gate(z, bgate, tb + qi[qs], hh, 1);
    const float* pp = part + (tb + qi[qs]) * DM + hh * 128;
    bf16_t* op = mix + (tb + qi[qs]) * DM + hh * 128;
#pragma unroll
    for (int dt = 0; dt < 8; ++dt) {
      const f32x4 pv = *(const f32x4*)(pp + dt * 16 + 4 * g);
      uint2 w; w.x = pack2(pv[0] + o[qs][dt][0] * inv, pv[1] + o[qs][dt][1] * inv); w.y = pack2(pv[2] + o[qs][dt][2] * inv, pv[3] + o[qs][dt][3] * inv);
      *(uint2*)(op + dt * 16 + 4 * g) = w;
    }
  }
}


#define XB_TMO      128
#define XB_XCNT(j)  (256  + 64 * (j))
#define XB_XSUB(j)  (1280 + 64 * (j))
#define XB_XGEN(j)  (2304 + 64 * (j))
#define XB_TOP      3328
#define XB_TOPGEN   3392
#define XCD_BAR_WORDS 3456
#define XB_SPIN_CAP (1u << 20)
#define LAS __attribute__((address_space(3)))
DI unsigned xb_ld(unsigned* p)              { return __hip_atomic_load(p, __ATOMIC_RELAXED, __HIP_MEMORY_SCOPE_AGENT); }
DI unsigned xb_add(unsigned* p, unsigned v) { return __hip_atomic_fetch_add(p, v, __ATOMIC_RELAXED, __HIP_MEMORY_SCOPE_AGENT); }
DI unsigned xb_xcc_id() { return (unsigned)__builtin_amdgcn_s_getreg((3 << 11) | 20) & 0xFu; }
#define XB_SPIN(cond, bar) do { unsigned _sp = 0; while (cond) { __builtin_amdgcn_s_sleep(1); \
    if ((++_sp & 255u) == 0u) { if (xb_ld(&(bar)[XB_TMO])) break; if (_sp > XB_SPIN_CAP) { atomicAdd(&(bar)[XB_TMO], 1u); break; } } } } while (0)
struct XcdBarrier { unsigned* bar; unsigned x; volatile LAS unsigned* st; };
DI XcdBarrier xcd_barrier_post(unsigned* bar, volatile LAS unsigned* st) {
  XcdBarrier b; b.bar = bar; b.x = xb_xcc_id(); b.st = st;
  if (threadIdx.x == 0) (void)xb_add(&bar[XB_XCNT(b.x)], 1u);
  return b;
}
DI void xcd_barrier_complete(unsigned* bar, unsigned x, unsigned& nloc, unsigned& nx) {
  const unsigned G = gridDim.x * gridDim.y * gridDim.z;
  unsigned sum, cnt, mine, sp = 0u;
  for (;;) {
    sum = 0u; cnt = 0u; mine = 0u;
#pragma unroll
    for (unsigned j = 0; j < 16; ++j) { const unsigned c = xb_ld(&bar[XB_XCNT(j)]); sum += c; cnt += (c > 0u) ? 1u : 0u; mine = (j == x) ? c : mine; }
    if (sum == G) break;
    __builtin_amdgcn_s_sleep(1);
    if ((++sp & 255u) == 0u) { if (xb_ld(&bar[XB_TMO])) break; if (sp > XB_SPIN_CAP) { atomicAdd(&bar[XB_TMO], 1u); break; } }
  }
  nloc = mine > 0u ? mine : 1u; nx = cnt > 0u ? cnt : 1u;
}
DI void xcd_barrier(const XcdBarrier& b) {
  asm volatile("s_waitcnt vmcnt(0)" ::: "memory");
  __syncthreads();
  if (threadIdx.x == 0) {
    unsigned* bar = b.bar;
    __builtin_amdgcn_s_waitcnt(0);
    unsigned nloc = b.st[0], nx = b.st[1];
    if (nloc == 0u) { xcd_barrier_complete(bar, b.x, nloc, nx); b.st[0] = nloc; b.st[1] = nx; }
    const unsigned old = xb_add(&bar[XB_XSUB(b.x)], 1u);
    const unsigned gen = old / nloc;
    if (old + 1u == (gen + 1u) * nloc) {
      __builtin_amdgcn_fence(__ATOMIC_RELEASE, "agent");
      asm volatile("s_waitcnt vmcnt(0)" ::: "memory");
      const unsigned og = xb_add(&bar[XB_TOP], 1u);
      const unsigned tg = og / nx;
      if (og + 1u == (tg + 1u) * nx) xb_add(&bar[XB_TOPGEN], 1u);
      else XB_SPIN(xb_ld(&bar[XB_TOPGEN]) == tg, bar);
      __builtin_amdgcn_fence(__ATOMIC_ACQUIRE, "agent");
      xb_add(&bar[XB_XGEN(b.x)], 1u);
      asm volatile("s_waitcnt vmcnt(0)" ::: "memory");
    } else {
      XB_SPIN(xb_ld(&bar[XB_XGEN(b.x)]) == gen, bar);
      __builtin_amdgcn_fence(__ATOMIC_ACQUIRE, "agent");
      asm volatile("s_waitcnt vmcnt(0)" ::: "memory");
    }
  }
  __syncthreads();
}

DI void flat_barrier(unsigned* cnt, unsigned target) {
  asm volatile("s_waitcnt vmcnt(0)" ::: "memory");
  __syncthreads();
  if (threadIdx.x == 0) {
    __builtin_amdgcn_fence(__ATOMIC_RELEASE, "agent");
    asm volatile("s_waitcnt vmcnt(0)" ::: "memory");
    (void)xb_add(cnt, 1u);
    unsigned sp = 0u;
    while (xb_ld(cnt) < target) { __builtin_amdgcn_s_sleep(1); if (++sp > (1u << 24)) break; }
    __builtin_amdgcn_fence(__ATOMIC_ACQUIRE, "agent");
    asm volatile("s_waitcnt vmcnt(0)" ::: "memory");
  }
  __syncthreads();
}

DI void hier_barrier(unsigned* bar, volatile LAS unsigned* st) {
  asm volatile("s_waitcnt vmcnt(0)" ::: "memory");
  __syncthreads();
  if (threadIdx.x == 0) {
    const unsigned x = blockIdx.x & 7u;
    __builtin_amdgcn_fence(__ATOMIC_RELEASE, "agent");
    asm volatile("s_waitcnt vmcnt(0)" ::: "memory");
    unsigned nloc = st[0], nx = st[1];
    if (nloc == 0u) { xcd_barrier_complete(bar, x, nloc, nx); st[0] = nloc; st[1] = nx; }
    const unsigned old = xb_add(&bar[XB_XSUB(x)], 1u);
    const unsigned gen = old / nloc;
    if (old + 1u == (gen + 1u) * nloc) {
      const unsigned og = xb_add(&bar[XB_TOP], 1u);
      const unsigned tg = og / nx;
      if (og + 1u == (tg + 1u) * nx) xb_add(&bar[XB_TOPGEN], 1u);
      else XB_SPIN(xb_ld(&bar[XB_TOPGEN]) == tg, bar);
      xb_add(&bar[XB_XGEN(x)], 1u);
    } else {
      XB_SPIN(xb_ld(&bar[XB_XGEN(x)]) == gen, bar);
    }
    __builtin_amdgcn_fence(__ATOMIC_ACQUIRE, "agent");
    asm volatile("s_waitcnt vmcnt(0)" ::: "memory");
  }
  __syncthreads();
}

__global__ void __launch_bounds__(256, 2) mega(Params p) {
  cg::grid_group grid = cg::this_grid();
  __shared__ __attribute__((aligned(16))) char smem[65536 + 16];
  char* ws = p.ws;
  if (threadIdx.x == 0) { *(unsigned*)(smem + 65536) = 0u; *(unsigned*)(smem + 65540) = 0u; }
  __syncthreads();
  const XcdBarrier xb = xcd_barrier_post((unsigned*)(ws + A_BAR), (volatile LAS unsigned*)LDSP(unsigned, smem + 65536));
  if (p.out == nullptr) grid.sync();
  const int* pos = (const int*)p.in[2];
  float* h = (float*)(ws + A_H);
  bf16_t* hn = (bf16_t*)(ws + A_HN);
  bf16_t* mix = (bf16_t*)(ws + A_MIX);
  float* mb = (float*)(ws + A_MB);
  float* rss = (float*)(ws + A_RSS);
  bf16_t* mbh = (bf16_t*)(ws + A_MB) + (size_t)TOK * DM;
  bf16_t* zb = (bf16_t*)(ws + A_R1);
  bf16_t* hid = (bf16_t*)(ws + A_R1);

  for (int j = 0; j < 2; ++j) {
    transpose_job(p.in[7] + (size_t)j * 2048 * ABN, 2048, ABN, ABP, (bf16_t*)(ws + W_ABIN) + (size_t)j * ABP * 2048, 0, smem);
    transpose_job(p.in[12] + (size_t)j * 512 * 1536, 512, 1536, 1536, (bf16_t*)(ws + W_UQ) + (size_t)j * 1536 * 512, 0, smem);
    transpose_job(p.in[14] + (size_t)j * 512 * 2048, 512, 2048, 2048, (bf16_t*)(ws + W_UKV) + (size_t)j * 2048 * 512, 0, smem);
    transpose_job(p.in[15] + (size_t)j * 2048 * 2048, 2048, 2048, 2048, (bf16_t*)(ws + W_ABOUT) + (size_t)j * 2048 * 2048, 0, smem);
    transpose_job(p.in[16] + (size_t)j * 2048 * NSN, 2048, NSN, NSP, (bf16_t*)(ws + W_NSIN) + (size_t)j * NSP * 2048, 0, smem);
    for (int kv = 0; kv < 2; ++kv) {
      transpose_job(p.in[19] + (size_t)(j * 2 + kv) * 4096 * 128, 4096, 128, 128, (bf16_t*)(ws + W_W1) + (size_t)(j * 2 + kv) * 128 * 4096, 0, smem);
      transpose_job(p.in[20] + (size_t)(j * 2 + kv) * 128 * 128, 128, 128, 128, (bf16_t*)(ws + W_W2) + (size_t)(j * 2 + kv) * 128 * 128, 0, smem);
    }
    transpose_job(p.in[21] + (size_t)j * 2048 * 2048, 2048, 2048, 2048, (bf16_t*)(ws + W_NSOUT) + (size_t)j * 2048 * 2048, 0, smem);
  }
  for (int i = 0; i < 4; ++i) {
    transpose_job(p.in[22] + (size_t)i * 2048 * FH, 2048, FH, FH, (bf16_t*)(ws + W_FGU) + (size_t)i * 11264 * 2048, 1, smem);
    transpose_job(p.in[23] + (size_t)i * 2048 * FH, 2048, FH, FH, (bf16_t*)(ws + W_FGU) + (size_t)i * 11264 * 2048, 2, smem);
    transpose_job(p.in[24] + (size_t)i * FH * 2048, FH, 2048, 2048, (bf16_t*)(ws + W_FD) + (size_t)i * 2048 * FH, 0, smem);
    transpose_job(p.in[25] + (size_t)i * 2048 * 2048, 2048, 2048, 2048, (bf16_t*)(ws + W_PG) + (size_t)i * 2048 * 2048, 0, smem);
    transpose_job(p.in[27] + (size_t)i * 256 * 2048, 256, 2048, 2048, (bf16_t*)(ws + W_PP) + (size_t)i * 2048 * 256, 0, smem);
  }
  {
    const float* pp = p.in[1]; bf16_t* pb = (bf16_t*)(ws + A_PBF);
    for (size_t i = (size_t)blockIdx.x * 256 + tidx(); i < (size_t)4 * TOK * 256 / 4; i += (size_t)gridDim.x * 256) {
      const f32x4 t4 = __builtin_nontemporal_load((const f32x4*)(pp + i * 4)); const float4 v = make_float4(t4[0], t4[1], t4[2], t4[3]);
      uint2 o; o.x = pack2(v.x, v.y); o.y = pack2(v.z, v.w);
      *(uint2*)(pb + i * 4) = o;
    }
  }
  row_pass(p.in[0], nullptr, nullptr, h, p.in[3], hn);
  xcd_barrier(xb);
  unsigned bepoch = 0u;

  for (int layer = 0; layer < 4; ++layer) {
    const int j = layer >> 1;
    GArgs ga{};
    if ((layer & 1) == 0) {
      ga = GArgs{}; ga.A = (layer == 0) ? hn : mix; ga.rowss = (layer == 0) ? nullptr : rss; ga.lda = DM; ga.Bt = (bf16_t*)(ws + W_ABIN) + (size_t)j * ABP * 2048; ga.K = 2048; ga.M = TOK; ga.Npad = 4096; ga.C = zb; ga.ldc = ABP;
      gemm_phase<EPI_BF16>(ga, smem);
      gemm_tail_splitk(ga.A, ga.Bt + (size_t)4096 * 2048, (float*)(ws + A_R3), smem);
      xcd_barrier(xb);
      bf16_t* cqn = (bf16_t*)(ws + A_R5); bf16_t* ckvn = cqn + (size_t)TOK * 512; bf16_t* krope = (bf16_t*)(ws + A_KR);
      float* ogla = (float*)(ws + A_R4);
      bf16_t* mq = (bf16_t*)(ws + A_R3); bf16_t* mkv = mq + (size_t)TOK * 1536;
      float* Ubuf = mb; float* Ebuf = mb + (size_t)10 * 1024 * 1024;
      for (int it = blockIdx.x; it < 1024; it += gridDim.x) gla_pass1(it, zb, p.in[8] + (size_t)j * 16 * 512, p.in[9] + (size_t)j * 512, Ubuf, Ebuf, smem);
      mla_prep(blockIdx.x, gridDim.x, zb, p.in[11] + j * 512, p.in[13] + j * 512, pos, cqn, ckvn, krope, (const float*)(ws + A_R3), (layer == 0) ? nullptr : rss);
      xcd_barrier(xb);
      gla_pass2(Ubuf, Ebuf);
      ga = GArgs{}; ga.A = cqn; ga.lda = 512; ga.Bt = (bf16_t*)(ws + W_UQ) + (size_t)j * 1536 * 512; ga.K = 512; ga.M = TOK; ga.Npad = 1536; ga.C = mq; ga.ldc = 1536;
      gemm_phase<EPI_BF16>(ga, smem);
      ga = GArgs{}; ga.A = ckvn; ga.lda = 512; ga.Bt = (bf16_t*)(ws + W_UKV) + (size_t)j * 2048 * 512; ga.K = 512; ga.M = TOK; ga.Npad = 2048; ga.C = mkv; ga.ldc = 2048;
      gemm_phase<EPI_BF16>(ga, smem);
      xcd_barrier(xb);
      for (int it = blockIdx.x; it < 1024; it += gridDim.x) gla_pass3(it, zb, p.in[8] + (size_t)j * 16 * 512, p.in[9] + (size_t)j * 512, Ubuf, p.in[10] + j * 128, mix, smem);
      {
        int r = 0;
        for (int base = 0; base < 32 * (SEQ / (64 * QS_MLA)); base += gridDim.x, ++r) {
          const int it = base + ((r & 1) ? (gridDim.x - 1 - blockIdx.x) : blockIdx.x);
          if (it < 32 * (SEQ / (64 * QS_MLA))) mla_attn_item<QS_MLA>(it, mq, mkv, krope, pos, mix, smem);
        }
      }
      xcd_barrier(xb);
      ga = GArgs{}; ga.A = mix; ga.lda = DM; ga.Bt = (bf16_t*)(ws + W_ABOUT) + (size_t)j * 2048 * 2048; ga.K = 2048; ga.M = TOK; ga.Npad = 2048; ga.C = mbh; ga.ldc = DM;
      gemm_phase<EPI_BF16>(ga, smem);
      xcd_barrier(xb);
    } else {
      ga = GArgs{}; ga.A = mix; ga.rowss = rss; ga.lda = DM; ga.Bt = (bf16_t*)(ws + W_NSIN) + (size_t)j * NSP * 2048; ga.K = 2048; ga.M = TOK; ga.Npad = 5120; ga.C = zb; ga.ldc = NSP;
      gemm_phase<EPI_BF16>(ga, smem);
      gemm_tail_splitk(ga.A, ga.Bt + (size_t)5120 * 2048, (float*)(ws + A_R3), smem);
      xcd_barrier(xb);
      bf16_t* aflk = (bf16_t*)(ws + A_R4); bf16_t* aflv = aflk + (size_t)2048 * 4096;
      bf16_t* hck = (bf16_t*)(ws + A_R5); bf16_t* hcv = hck + 2048 * 128; bf16_t* kcmp = hcv + 2048 * 128; bf16_t* vcmp = kcmp + 2048 * 128;
      float* P = (float*)(ws + A_R3);
      unsigned* sel = (unsigned*)(ws + A_SEL);
      const float* bgate = p.in[17] + j * 48;
      nsa_prep(zb, pos, p.in[18] + (size_t)j * 2 * 4096, aflk, aflv, (const float*)(ws + A_R3), rss);
      xcd_barrier(xb);
      ga = GArgs{}; ga.A = aflk; ga.lda = 4096; ga.Bt = (bf16_t*)(ws + W_W1) + (size_t)(j * 2) * 128 * 4096; ga.K = 4096; ga.M = 2048; ga.Npad = 128; ga.C = hck; ga.ldc = 128;
      gemm_phase<EPI_GELU>(ga, smem);
      ga.A = aflv; ga.Bt = (bf16_t*)(ws + W_W1) + (size_t)(j * 2 + 1) * 128 * 4096; ga.C = hcv;
      gemm_phase<EPI_GELU>(ga, smem);
      xcd_barrier(xb);
      ga = GArgs{}; ga.A = hck; ga.lda = 128; ga.Bt = (bf16_t*)(ws + W_W2) + (size_t)(j * 2) * 128 * 128; ga.K = 128; ga.M = 2048; ga.Npad = 128; ga.C = kcmp; ga.ldc = 128;
      gemm_phase<EPI_BF16>(ga, smem);
      ga.A = hcv; ga.Bt = (bf16_t*)(ws + W_W2) + (size_t)(j * 2 + 1) * 128 * 128; ga.C = vcmp;
      gemm_phase<EPI_BF16>(ga, smem);
      xcd_barrier(xb);
      for (int it = blockIdx.x; it < 64 * (SEQ / (64 * QS_CW)); it += gridDim.x) nsa_cmpwin_item<QS_CW>(it, zb, kcmp, vcmp, bgate, P, mb, smem);
      xcd_barrier(xb);
      nsa_select(P, sel);
      xcd_barrier(xb);
      {
        int r = 0;
        for (int base = 0; base < 64 * (SEQ / (64 * QS_SEL)); base += gridDim.x, ++r) {
          const int it = base + ((r & 1) ? (gridDim.x - 1 - blockIdx.x) : blockIdx.x);
          if (it < 64 * (SEQ / (64 * QS_SEL))) nsa_sel_item<QS_SEL>(it, zb, sel, bgate, mb, mix, smem);
        }
      }
      xcd_barrier(xb);
      ga = GArgs{}; ga.A = mix; ga.lda = DM; ga.Bt = (bf16_t*)(ws + W_NSOUT) + (size_t)j * 2048 * 2048; ga.K = 2048; ga.M = TOK; ga.Npad = 2048; ga.C = mbh; ga.ldc = DM;
      gemm_phase<EPI_BF16>(ga, smem);
      xcd_barrier(xb);
    }
    row_pass(nullptr, mbh, p.in[4] + layer * DM, h, p.in[5] + layer * DM, hn);
    xcd_barrier(xb);
    ga = GArgs{}; ga.A = hn; ga.lda = DM; ga.Bt = (bf16_t*)(ws + W_FGU) + (size_t)layer * 11264 * 2048; ga.K = 2048; ga.M = TOK; ga.Npad = 11264; ga.C = hid; ga.ldc = FH;
    gemm_phase<EPI_SWIGLU>(ga, smem);
    xcd_barrier(xb);
    ga = GArgs{}; ga.A = hid; ga.lda = FH; ga.Bt = (bf16_t*)(ws + W_FD) + (size_t)layer * 2048 * FH; ga.K = FH; ga.M = TOK; ga.Npad = 2048; ga.C = mbh; ga.ldc = DM;
    gemm_phase<EPI_BF16>(ga, smem);
    xcd_barrier(xb);
    row_pass(nullptr, mbh, p.in[6] + layer * DM, h, nullptr, hn);
    xcd_barrier(xb);
    ga = GArgs{}; ga.A = hn; ga.lda = DM; ga.Bt = (bf16_t*)(ws + W_PG) + (size_t)layer * 2048 * 2048; ga.K = 2048; ga.M = TOK; ga.Npad = 2048;
    ga.A2 = (bf16_t*)(ws + A_PBF) + (size_t)layer * TOK * 256; ga.lda2 = 256; ga.Bt2 = (bf16_t*)(ws + W_PP) + (size_t)layer * 2048 * 256; ga.K2 = 256;
    ga.bias = p.in[26] + layer * DM; ga.hsrc = h; ga.C = (layer == 3) ? p.out : h; ga.ldc = DM;
    if (layer < 3) { ga.wnext = p.in[3] + (layer + 1) * DM; ga.hnext = mix; ga.rss = rss; }
    gemm_phase<EPI_PLE>(ga, smem);
    if (layer < 3) xcd_barrier(xb);
  }
}

extern "C" void kernel_launch(void* const* d_in, const int* in_sizes, int n_in, void* d_out, int out_size,
                              void* d_ws, size_t ws_size, hipStream_t stream) {
  static int grid_blocks = 0;
  if (!grid_blocks) {
    int dev = 0, cus = 0, per_cu = 0;
    (void)hipGetDevice(&dev);
    (void)hipDeviceGetAttribute(&cus, hipDeviceAttributeMultiprocessorCount, dev);
    (void)hipOccupancyMaxActiveBlocksPerMultiprocessor(&per_cu, mega, 256, 0);
    if (per_cu > 2) per_cu = 2;
    if (per_cu < 1) per_cu = 1;
    grid_blocks = cus * per_cu;
  }
  if (ws_size < WS_NEED) { fprintf(stderr, "workspace too small: %zu < %zu\n", ws_size, (size_t)WS_NEED); return; }
  Params p{};
  for (int i = 0; i < 28; ++i) p.in[i] = (const float*)d_in[i];
  p.out = (float*)d_out; p.ws = (char*)d_ws;
  void* args[] = {&p};
  (void)hipMemsetAsync((char*)d_ws + A_BAR, 0, 4096 * 4, stream);
  hipError_t e = hipLaunchCooperativeKernel((void*)mega, dim3(grid_blocks), dim3(256), args, 0, stream);
  if (e != hipSuccess) fprintf(stderr, "coop launch failed: %s (grid %d)\n", hipGetErrorString(e), grid_blocks);
}
```

```cpp
#include <hip/hip_runtime.h>
#include <hip/hip_cooperative_groups.h>
#include <cstdio>
#include <cstdint>
namespace cg = cooperative_groups;

typedef unsigned short bf16_t;
typedef short bf16x8 __attribute__((ext_vector_type(8)));
typedef short s16x4 __attribute__((ext_vector_type(4)));
typedef float f32x4 __attribute__((ext_vector_type(4)));
typedef unsigned u32x4 __attribute__((ext_vector_type(4)));
typedef unsigned u32x2 __attribute__((ext_vector_type(2)));
#define DI __device__ __forceinline__
#define LDSP(T, p) ((__attribute__((address_space(3))) T*)(p))

constexpr int TOK = 8192, SEQ = 2048, DM = 2048, NB = 4;
constexpr int ABN = 4176, ABP = 4224;
constexpr int NSN = 5168, NSP = 5248;
constexpr int FH = 5632;
constexpr int QS_MLA = 2, QS_CW = 2, QS_SEL = 2;
#define QB (64 * QS)
#define NQT (SEQ / QB)
constexpr int ZQ = 0, ZK = 512, ZV = 1024, ZG = 2048, ZA = 3072, ZCQ = 3088, ZCKV = 3600, ZKR = 4112;
constexpr int NQ = 0, NKC = 2048, NVC = 2560, NKS = 3072, NVS = 3584, NKW = 4096, NVW = 4608, NGL = 5120;

constexpr size_t al(size_t x) { return (x + 255) & ~(size_t)255; }
constexpr size_t W_ABIN = 0;
constexpr size_t W_UQ = W_ABIN + al((size_t)2 * ABP * 2048 * 2);
constexpr size_t W_UKV = W_UQ + al((size_t)2 * 1536 * 512 * 2);
constexpr size_t W_ABOUT = W_UKV + al((size_t)2 * 2048 * 512 * 2);
constexpr size_t W_NSIN = W_ABOUT + al((size_t)2 * 2048 * 2048 * 2);
constexpr size_t W_W1 = W_NSIN + al((size_t)2 * NSP * 2048 * 2);
constexpr size_t W_W2 = W_W1 + al((size_t)4 * 128 * 4096 * 2);
constexpr size_t W_NSOUT = W_W2 + al((size_t)4 * 128 * 128 * 2);
constexpr size_t W_FGU = W_NSOUT + al((size_t)2 * 2048 * 2048 * 2);
constexpr size_t W_FD = W_FGU + al((size_t)4 * 11264 * 2048 * 2);
constexpr size_t W_PG = W_FD + al((size_t)4 * 2048 * 5632 * 2);
constexpr size_t W_PP = W_PG + al((size_t)4 * 2048 * 2048 * 2);
constexpr size_t A_PBF = W_PP + al((size_t)4 * 2048 * 256 * 2);
constexpr size_t A_H = A_PBF + al((size_t)4 * TOK * 256 * 2);
constexpr size_t A_HN = A_H + al((size_t)TOK * 2048 * 4);
constexpr size_t A_MIX = A_HN + al((size_t)TOK * 2048 * 2);
constexpr size_t A_MB = A_MIX + al((size_t)TOK * 2048 * 2);
constexpr size_t A_R1 = A_MB + al((size_t)TOK * 2048 * 4);
constexpr size_t A_R3 = A_R1 + al((size_t)TOK * 5632 * 2);
constexpr size_t A_R4 = A_R3 + al((size_t)4 * 16 * 2048 * 128 * 4);
constexpr size_t A_R5 = A_R4 + al((size_t)2 * 2048 * 4096 * 2);
constexpr size_t A_KR = A_R5 + al((size_t)2 * TOK * 512 * 2);
constexpr size_t A_SEL = A_KR + al((size_t)TOK * 64 * 2);
constexpr size_t A_BAR = A_SEL + al((size_t)16 * 2048 * 4);
constexpr size_t A_RSS = A_BAR + al((size_t)4096 * 4);
constexpr size_t WS_NEED = A_RSS + al((size_t)TOK * 16 * 4);

struct Params {
  const float* in[28];
  float* out;
  char* ws;
};

DI float bf2f(bf16_t v) { return __uint_as_float(((unsigned)v) << 16); }
DI unsigned pack2(float lo, float hi) { unsigned r; asm("v_cvt_pk_bf16_f32 %0, %1, %2" : "=v"(r) : "v"(lo), "v"(hi)); return r; }
DI bf16_t f2bf(float f) { return (bf16_t)(pack2(f, 0.f) & 0xffffu); }
DI float lo2f(unsigned u) { return __uint_as_float(u << 16); }
DI float hi2f(unsigned u) { return __uint_as_float(u & 0xffff0000u); }
DI float wave_sum(float v) {
#pragma unroll
  for (int o = 32; o > 0; o >>= 1) v += __shfl_xor(v, o);
  return v;
}
DI int tidx() { int t = threadIdx.x; asm volatile("" : "+v"(t)); return t; }
DI f32x4 zero4() { float z0 = 0.f; asm volatile("" : "+v"(z0)); return (f32x4){z0, z0, z0, z0}; }
DI float sigmoidf_(float x) { return 1.f / (1.f + __expf(-x)); }
DI void rope_cs(int pos, int i, float l2step, float& c, float& s) {
  float inv = exp2f(-(float)i * l2step);
  float ang = (float)pos * inv;
  float rev = ang * 0.15915494309189535f;
  rev -= floorf(rev);
  c = __builtin_amdgcn_cosf(rev);
  s = __builtin_amdgcn_sinf(rev);
}

DI void transpose_job(const float* __restrict__ src, int K, int N, int Npad, bf16_t* __restrict__ dst, int mode, char* smem) {
  float* t = (float*)smem;
  const int tn = Npad / 64, tk = K / 64, tid = tidx();
  for (int tile = blockIdx.x; tile < tn * tk; tile += gridDim.x) {
    const int n0 = (tile % tn) * 64, k0 = (tile / tn) * 64;
#pragma unroll
    for (int i = 0; i < 4; ++i) {
      const int kr = (tid >> 4) + 16 * i, nc = (tid & 15) * 4, n = n0 + nc;
      float4 v = make_float4(0.f, 0.f, 0.f, 0.f);
      if (n < N) { const f32x4 t4 = __builtin_nontemporal_load((const f32x4*)(src + (size_t)(k0 + kr) * N + n)); v = make_float4(t4[0], t4[1], t4[2], t4[3]); }
      t[kr * 65 + nc + 0] = v.x; t[kr * 65 + nc + 1] = v.y; t[kr * 65 + nc + 2] = v.z; t[kr * 65 + nc + 3] = v.w;
    }
    __syncthreads();
    {
      const int nr = tid >> 2, kq = (tid & 3) * 16, n = n0 + nr;
      unsigned w[8];
#pragma unroll
      for (int e = 0; e < 8; ++e) w[e] = pack2(t[(kq + 2 * e) * 65 + nr], t[(kq + 2 * e + 1) * 65 + nr]);
      int row = n;
      if (mode == 1) row = (n >> 6) * 128 + (n & 63);
      else if (mode == 2) row = (n >> 6) * 128 + 64 + (n & 63);
      u32x4* d = (u32x4*)(dst + (size_t)row * K + k0 + kq);
      __builtin_nontemporal_store((u32x4){w[0], w[1], w[2], w[3]}, d);
      __builtin_nontemporal_store((u32x4){w[4], w[5], w[6], w[7]}, d + 1);
    }
    __syncthreads();
  }
}

DI void row_pass(const float* __restrict__ init, const bf16_t* __restrict__ add, const float* __restrict__ wpost,
                         float* __restrict__ h, const float* __restrict__ wnext, bf16_t* __restrict__ hn, float* __restrict__ zero_rss = nullptr) {
  const int tid = tidx(), lane = tid & 63, wv = tid >> 6;
  for (int row = blockIdx.x * 4 + wv; row < TOK; row += gridDim.x * 4) {
    const size_t ro = (size_t)row * DM;
    if (zero_rss && lane == 0) zero_rss[row] = 0.f;
    float4 hv[8];
    const float* hs = init ? init : h;
#pragma unroll
    for (int i = 0; i < 8; ++i) hv[i] = *(const float4*)(hs + ro + i * 256 + lane * 4);
    if (add) {
      float4 av[8]; float ss = 0.f;
#pragma unroll
      for (int i = 0; i < 8; ++i) { const u32x2 a2 = *(const u32x2*)(add + ro + i * 256 + lane * 4); av[i] = make_float4(lo2f(a2[0]), hi2f(a2[0]), lo2f(a2[1]), hi2f(a2[1])); ss += av[i].x * av[i].x + av[i].y * av[i].y + av[i].z * av[i].z + av[i].w * av[i].w; }
      ss = wave_sum(ss);
      const float r = rsqrtf(ss * (1.f / DM) + 1e-6f);
#pragma unroll
      for (int i = 0; i < 8; ++i) {
        const float4 w = *(const float4*)(wpost + i * 256 + lane * 4);
        hv[i].x += av[i].x * r * w.x; hv[i].y += av[i].y * r * w.y; hv[i].z += av[i].z * r * w.z; hv[i].w += av[i].w * r * w.w;
      }
    }
    if (add || init) {
#pragma unroll
      for (int i = 0; i < 8; ++i) *(float4*)(h + ro + i * 256 + lane * 4) = hv[i];
    }
    float r2 = 1.f;
    if (wnext) {
      float ss = 0.f;
#pragma unroll
      for (int i = 0; i < 8; ++i) ss += hv[i].x * hv[i].x + hv[i].y * hv[i].y + hv[i].z * hv[i].z + hv[i].w * hv[i].w;
      ss = wave_sum(ss);
      r2 = rsqrtf(ss * (1.f / DM) + 1e-6f);
    }
#pragma unroll
    for (int i = 0; i < 8; ++i) {
      float4 w = make_float4(1.f, 1.f, 1.f, 1.f);
      if (wnext) w = *(const float4*)(wnext + i * 256 + lane * 4);
      uint2 o; o.x = pack2(hv[i].x * r2 * w.x, hv[i].y * r2 * w.y); o.y = pack2(hv[i].z * r2 * w.z, hv[i].w * r2 * w.w);
      *(uint2*)(hn + ro + i * 256 + lane * 4) = o;
    }
  }
}

DI int toff(int row, int chunk) { return row * 128 + ((chunk ^ ((row >> 1) & 7)) << 4); }

DI void gemm_issue_first(const bf16_t* __restrict__ A, int lda, const bf16_t* __restrict__ Bt, int ldb, int m0, int n0, char* smem) {
  const int tid = tidx(), wave = tid >> 6, lane = tid & 63;
#pragma unroll
  for (int i = 0; i < 4; ++i) {
    const int row = (i * 4 + wave) * 8 + (lane >> 3), chunk = (lane & 7) ^ ((row >> 1) & 7);
    __builtin_amdgcn_global_load_lds((const unsigned*)(A + (size_t)(m0 + row) * lda + chunk * 8), LDSP(unsigned, smem + (i * 4 + wave) * 1024), 16, 0, 0);
    __builtin_amdgcn_global_load_lds((const unsigned*)(Bt + (size_t)(n0 + row) * ldb + chunk * 8), LDSP(unsigned, smem + 16384 + (i * 4 + wave) * 1024), 16, 0, 0);
  }
}
#define DSR(dst, addr, off) asm volatile("ds_read_b128 %0, %1 offset:%2" : "=v"(dst) : "v"(addr), "n"(off) : "memory")
template <bool DEEP = false>
DI void gemm_mainloop(const bf16_t* __restrict__ A, int lda, const bf16_t* __restrict__ Bt, int ldb, int K, int m0, int n0,
                      f32x4 (&acc)[2][8], char* smem, bool prefetched = false) {
  const int tid = tidx(), wave = tid >> 6, lane = tid & 63;
  const bf16_t* ag[4]; const bf16_t* bg[4];
#pragma unroll
  for (int i = 0; i < 4; ++i) {
    const int row = (i * 4 + wave) * 8 + (lane >> 3), chunk = (lane & 7) ^ ((row >> 1) & 7);
    ag[i] = A + (size_t)(m0 + row) * lda + chunk * 8;
    bg[i] = Bt + (size_t)(n0 + row) * ldb + chunk * 8;
  }
  const int nk = K >> 6;
#define GSTAGE(buf, kt)                                                                                                   \
  _Pragma("unroll") for (int i = 0; i < 4; ++i) {                                                                         \
    __builtin_amdgcn_global_load_lds((const unsigned*)(ag[i] + (kt) * 64), LDSP(unsigned, smem + (buf) * 32768 + (i * 4 + wave) * 1024), 16, 0, 0);          \
    __builtin_amdgcn_global_load_lds((const unsigned*)(bg[i] + (kt) * 64), LDSP(unsigned, smem + (buf) * 32768 + 16384 + (i * 4 + wave) * 1024), 16, 0, 0);  \
  }
  if (!prefetched) { GSTAGE(0, 0); }
  asm volatile("s_waitcnt vmcnt(0)" ::: "memory");
  __syncthreads();
#pragma unroll 1
  for (int kt = 0; kt < nk; ++kt) {
    const int cur = kt & 1;
    if (kt + 1 < nk) { GSTAGE(cur ^ 1, kt + 1); }
    const char* As = smem + cur * 32768; const char* Bs = As + 16384;
    if (DEEP) {
      const unsigned i16 = lane & 15, gq = lane >> 4, sw = (i16 >> 1) & 7;
      const unsigned base = (unsigned)(size_t)smem + cur * 32768 + i16 * 128;
      const unsigned a0 = base + wave * 4096 + ((gq ^ sw) << 4), a1 = base + wave * 4096 + (((4 + gq) ^ sw) << 4);
      const unsigned b0 = base + 16384 + ((gq ^ sw) << 4), b1 = base + 16384 + (((4 + gq) ^ sw) << 4);
      bf16x8 af[2][2], bfr[2][8];
      DSR(af[0][0], a0, 0); DSR(af[0][1], a0, 2048);
      DSR(bfr[0][0], b0, 0); DSR(bfr[0][1], b0, 2048); DSR(bfr[0][2], b0, 4096); DSR(bfr[0][3], b0, 6144);
      DSR(bfr[0][4], b0, 8192); DSR(bfr[0][5], b0, 10240); DSR(bfr[0][6], b0, 12288); DSR(bfr[0][7], b0, 14336);
      DSR(af[1][0], a1, 0); DSR(af[1][1], a1, 2048);
      DSR(bfr[1][0], b1, 0); DSR(bfr[1][1], b1, 2048); DSR(bfr[1][2], b1, 4096); DSR(bfr[1][3], b1, 6144);
      DSR(bfr[1][4], b1, 8192); DSR(bfr[1][5], b1, 10240); DSR(bfr[1][6], b1, 12288); DSR(bfr[1][7], b1, 14336);
      __builtin_amdgcn_sched_barrier(0);
      asm volatile("s_waitcnt lgkmcnt(10)" ::: "memory");
      __builtin_amdgcn_sched_barrier(0);
#pragma unroll
      for (int mi = 0; mi < 2; ++mi)
#pragma unroll
        for (int ni = 0; ni < 8; ++ni) acc[mi][ni] = __builtin_amdgcn_mfma_f32_16x16x32_bf16(bfr[0][ni], af[0][mi], acc[mi][ni], 0, 0, 0);
      __builtin_amdgcn_sched_barrier(0);
      asm volatile("s_waitcnt lgkmcnt(0)" ::: "memory");
      __builtin_amdgcn_sched_barrier(0);
#pragma unroll
      for (int mi = 0; mi < 2; ++mi)
#pragma unroll
        for (int ni = 0; ni < 8; ++ni) acc[mi][ni] = __builtin_amdgcn_mfma_f32_16x16x32_bf16(bfr[1][ni], af[1][mi], acc[mi][ni], 0, 0, 0);
      __builtin_amdgcn_sched_barrier(0);
    } else
#pragma unroll
    for (int ks = 0; ks < 2; ++ks) {
      const int chunk = ks * 4 + (lane >> 4);
      bf16x8 af[2], bfr[8];
#pragma unroll
      for (int mi = 0; mi < 2; ++mi) af[mi] = *(const bf16x8*)(As + toff(wave * 32 + mi * 16 + (lane & 15), chunk));
#pragma unroll
      for (int ni = 0; ni < 8; ++ni) bfr[ni] = *(const bf16x8*)(Bs + toff(ni * 16 + (lane & 15), chunk));
#pragma unroll
      for (int mi = 0; mi < 2; ++mi)
#pragma unroll
        for (int ni = 0; ni < 8; ++ni) acc[mi][ni] = __builtin_amdgcn_mfma_f32_16x16x32_bf16(bfr[ni], af[mi], acc[mi][ni], 0, 0, 0);
    }
    asm volatile("s_waitcnt vmcnt(0)" ::: "memory");
    __syncthreads();
  }
#undef GSTAGE
}
DI void gemm_mainloop_deep(const bf16_t* __restrict__ A, int lda, const bf16_t* __restrict__ Bt, int ldb, int K, int m0, int n0,
                           f32x4 (&acc)[2][8], char* smem, bool prefetched) {
  const int tid = tidx(), wave = tid >> 6, lane = tid & 63;
  const bf16_t* ag[4]; const bf16_t* bg[4];
#pragma unroll
  for (int i = 0; i < 4; ++i) {
    const int row = (i * 4 + wave) * 8 + (lane >> 3), chunk = (lane & 7) ^ ((row >> 1) & 7);
    ag[i] = A + (size_t)(m0 + row) * lda + chunk * 8;
    bg[i] = Bt + (size_t)(n0 + row) * ldb + chunk * 8;
  }
  const int nk = K >> 6;
#define GSTAGE(buf, kt)                                                                                                   \
  _Pragma("unroll") for (int i = 0; i < 4; ++i) {                                                                         \
    __builtin_amdgcn_global_load_lds((const unsigned*)(ag[i] + (kt) * 64), LDSP(unsigned, smem + (buf) * 32768 + (i * 4 + wave) * 1024), 16, 0, 0);          \
    __builtin_amdgcn_global_load_lds((const unsigned*)(bg[i] + (kt) * 64), LDSP(unsigned, smem + (buf) * 32768 + 16384 + (i * 4 + wave) * 1024), 16, 0, 0);  \
  }
#define RDSET(S, abase, bbase)                                                                                            \
  DSR(af[S][0], abase, 0); DSR(af[S][1], abase, 2048);                                                                    \
  DSR(bfr[S][0], bbase, 0); DSR(bfr[S][1], bbase, 2048); DSR(bfr[S][2], bbase, 4096); DSR(bfr[S][3], bbase, 6144);        \
  DSR(bfr[S][4], bbase, 8192); DSR(bfr[S][5], bbase, 10240); DSR(bfr[S][6], bbase, 12288); DSR(bfr[S][7], bbase, 14336);
#define MMSET(S)                                                                                                          \
  _Pragma("unroll") for (int mi = 0; mi < 2; ++mi)                                                                        \
  _Pragma("unroll") for (int ni = 0; ni < 8; ++ni) acc[mi][ni] = __builtin_amdgcn_mfma_f32_16x16x32_bf16(bfr[S][ni], af[S][mi], acc[mi][ni], 0, 0, 0);
  const unsigned i16 = lane & 15, gq = lane >> 4, sw = (i16 >> 1) & 7;
  const unsigned lb = (unsigned)(size_t)smem + i16 * 128;
  const unsigned o0 = (gq ^ sw) << 4, o1 = ((4 + gq) ^ sw) << 4;
  bf16x8 af[2][2], bfr[2][8];
  if (!prefetched) { GSTAGE(0, 0); }
  asm volatile("s_waitcnt vmcnt(0)" ::: "memory");
  __syncthreads();
  if (nk > 1) { GSTAGE(1, 1); }
  { const unsigned a = lb + wave * 4096 + o0, b = lb + 16384 + o0; RDSET(0, a, b); }
#pragma unroll 1
  for (int kt = 0; kt < nk; ++kt) {
    const unsigned cb = lb + (kt & 1) * 32768, nb = lb + ((kt & 1) ^ 1) * 32768;
    { const unsigned a = cb + wave * 4096 + o1, b = cb + 16384 + o1; RDSET(1, a, b); }
    __builtin_amdgcn_sched_barrier(0);
    asm volatile("s_waitcnt lgkmcnt(10)" ::: "memory");
    __builtin_amdgcn_sched_barrier(0);
    MMSET(0)
    __builtin_amdgcn_sched_barrier(0);
    asm volatile("s_waitcnt lgkmcnt(0)\n\ts_waitcnt vmcnt(0)" ::: "memory");
    __syncthreads();
    __builtin_amdgcn_sched_barrier(0);
    if (kt + 2 < nk) { GSTAGE(kt & 1, kt + 2); }
    if (kt + 1 < nk) { const unsigned a = nb + wave * 4096 + o0, b = nb + 16384 + o0; RDSET(0, a, b); }
    __builtin_amdgcn_sched_barrier(0);
    MMSET(1)
    __builtin_amdgcn_sched_barrier(0);
  }
#undef GSTAGE
#undef RDSET
#undef MMSET
}

enum { EPI_BF16 = 0, EPI_F32 = 1, EPI_SWIGLU = 2, EPI_GELU = 3, EPI_PLE = 4 };
struct GArgs {
  const bf16_t* A; int lda; const bf16_t* Bt; int K; int M; int Npad;
  void* C; int ldc;
  const bf16_t* A2; int lda2; const bf16_t* Bt2; int K2;
  const float* bias; const float* hsrc;
  const float* wnext; bf16_t* hnext; float* rss;
  const float* rowss;
};
DI float gelu_tanh(float x) {
  const float u = 0.7978845608028654f * (x + 0.044715f * x * x * x);
  const float t = 1.f - 2.f / (1.f + __expf(2.f * u));
  return 0.5f * x * (1.f + t);
}
template <int EPI>
DI void gemm_phase(const GArgs& g, char* smem) {
  const int ntm = g.M / 128, ntn = g.Npad / 128;
  const int tid = tidx(), lane = tid & 63, wave = tid >> 6;
  if (EPI != EPI_PLE && (int)blockIdx.x < ntm * ntn) gemm_issue_first(g.A, g.lda, g.Bt, g.K, (blockIdx.x % ntm) * 128, (blockIdx.x / ntm) * 128, smem);
  for (int tile = blockIdx.x; tile < ntm * ntn; tile += gridDim.x) {
    const int m0 = (tile % ntm) * 128, n0 = (tile / ntm) * 128;
    f32x4 acc[2][8];
#pragma unroll
    for (int mi = 0; mi < 2; ++mi)
#pragma unroll
      for (int ni = 0; ni < 8; ++ni) acc[mi][ni] = zero4();
    if (EPI != EPI_PLE) gemm_mainloop_deep(g.A, g.lda, g.Bt, g.K, g.K, m0, n0, acc, smem, true);
    else gemm_mainloop<false>(g.A, g.lda, g.Bt, g.K, g.K, m0, n0, acc, smem, false);
    if (EPI != EPI_PLE) {
      const int nt = tile + gridDim.x;
      if (nt < ntm * ntn) gemm_issue_first(g.A, g.lda, g.Bt, g.K, (nt % ntm) * 128, (nt / ntm) * 128, smem);
    }
    if (EPI == EPI_PLE) {
      f32x4 acc2[2][8];
#pragma unroll
      for (int mi = 0; mi < 2; ++mi)
#pragma unroll
        for (int ni = 0; ni < 8; ++ni) acc2[mi][ni] = zero4();
      gemm_mainloop(g.A2, g.lda2, g.Bt2, g.K2, g.K2, m0, n0, acc2, smem);
#pragma unroll
      for (int mi = 0; mi < 2; ++mi) {
        const int row = m0 + wave * 32 + mi * 16 + (lane & 15);
        float ssq = 0.f;
#pragma unroll
        for (int ni = 0; ni < 8; ++ni) {
          const int col = n0 + ni * 16 + (lane >> 4) * 4;
          const float4 hb = *(const float4*)(g.hsrc + (size_t)row * DM + col);
          const float4 bb = *(const float4*)(g.bias + col);
          float4 o;
          o.x = hb.x + sigmoidf_(acc[mi][ni][0] + bb.x) * acc2[mi][ni][0];
          o.y = hb.y + sigmoidf_(acc[mi][ni][1] + bb.y) * acc2[mi][ni][1];
          o.z = hb.z + sigmoidf_(acc[mi][ni][2] + bb.z) * acc2[mi][ni][2];
          o.w = hb.w + sigmoidf_(acc[mi][ni][3] + bb.w) * acc2[mi][ni][3];
          *(float4*)((float*)g.C + (size_t)row * DM + col) = o;
          if (g.hnext) {
            const float4 wn = *(const float4*)(g.wnext + col);
            u32x2 hb2; hb2[0] = pack2(o.x * wn.x, o.y * wn.y); hb2[1] = pack2(o.z * wn.z, o.w * wn.w);
            *(u32x2*)(g.hnext + (size_t)row * DM + col) = hb2;
            ssq += o.x * o.x + o.y * o.y + o.z * o.z + o.w * o.w;
          }
        }
        if (g.hnext) {
          ssq += __shfl_xor(ssq, 16); ssq += __shfl_xor(ssq, 32);
          if (lane < 16) g.rss[(size_t)row * 16 + (n0 >> 7)] = ssq;
        }
      }
    } else {
#pragma unroll
      for (int mi = 0; mi < 2; ++mi) {
        const int row = m0 + wave * 32 + mi * 16 + (lane & 15);
        float rsc = 1.f;
        if (EPI == EPI_BF16) {
          if (g.rowss) {
            const f32x4* rp = (const f32x4*)(g.rowss + (size_t)row * 16);
            const f32x4 a0 = rp[0], a1 = rp[1], a2 = rp[2], a3 = rp[3];
            const float tot = ((a0[0] + a0[1]) + (a0[2] + a0[3])) + ((a1[0] + a1[1]) + (a1[2] + a1[3])) + ((a2[0] + a2[1]) + (a2[2] + a2[3])) + ((a3[0] + a3[1]) + (a3[2] + a3[3]));
            rsc = rsqrtf(tot * (1.f / DM) + 1e-6f);
          }
        }
        if (EPI == EPI_SWIGLU) {
#pragma unroll
          for (int ni = 0; ni < 4; ++ni) {
            const int col = (n0 >> 1) + ni * 16 + (lane >> 4) * 4;
            float v[4];
#pragma unroll
            for (int r = 0; r < 4; ++r) { const float gt = acc[mi][ni][r]; v[r] = gt * sigmoidf_(gt) * acc[mi][ni + 4][r]; }
            uint2 o; o.x = pack2(v[0], v[1]); o.y = pack2(v[2], v[3]);
            *(uint2*)((bf16_t*)g.C + (size_t)row * g.ldc + col) = o;
          }
        } else {
#pragma unroll
          for (int ni = 0; ni < 8; ++ni) {
            const int col = n0 + ni * 16 + (lane >> 4) * 4;
            if (EPI == EPI_F32) {
              *(f32x4*)((float*)g.C + (size_t)row * g.ldc + col) = acc[mi][ni];
            } else {
              float v[4];
#pragma unroll
              for (int r = 0; r < 4; ++r) v[r] = (EPI == EPI_GELU) ? gelu_tanh(acc[mi][ni][r]) : acc[mi][ni][r] * rsc;
              uint2 o; o.x = pack2(v[0], v[1]); o.y = pack2(v[2], v[3]);
              *(uint2*)((bf16_t*)g.C + (size_t)row * g.ldc + col) = o;
            }
          }
        }
      }
    }
  }
}

DI void gemm_tail_splitk(const bf16_t* __restrict__ A, const bf16_t* __restrict__ Bt_tail, float* __restrict__ slab, char* smem) {
  const int tid = tidx(), lane = tid & 63, wave = tid >> 6;
  for (int u = blockIdx.x; u < 512; u += gridDim.x) {
    const int mt = u & 63, ks = u >> 6;
    f32x4 acc[2][8];
#pragma unroll
    for (int mi = 0; mi < 2; ++mi)
#pragma unroll
      for (int ni = 0; ni < 8; ++ni) acc[mi][ni] = zero4();
    gemm_mainloop(A + ks * 256, DM, Bt_tail + ks * 256, DM, 256, mt * 128, 0, acc, smem);
#pragma unroll
    for (int mi = 0; mi < 2; ++mi) {
      const int row = mt * 128 + wave * 32 + mi * 16 + (lane & 15);
#pragma unroll
      for (int ni = 0; ni < 8; ++ni) *(f32x4*)(slab + ((size_t)ks * TOK + row) * 128 + ni * 16 + (lane >> 4) * 4) = acc[mi][ni];
    }
  }
}
DI float row_rsc(const float* __restrict__ rowss, int row) {
  if (!rowss) return 1.f;
  const f32x4* rp = (const f32x4*)(rowss + (size_t)row * 16);
  const f32x4 a0 = rp[0], a1 = rp[1], a2 = rp[2], a3 = rp[3];
  const float tot = ((a0[0] + a0[1]) + (a0[2] + a0[3])) + ((a1[0] + a1[1]) + (a1[2] + a1[3])) + ((a2[0] + a2[1]) + (a2[2] + a2[3])) + ((a3[0] + a3[1]) + (a3[2] + a3[3]));
  return rsqrtf(tot * (1.f / DM) + 1e-6f);
}
DI float slab_sum(const float* __restrict__ slab, int tok, int col) {
  float v = 0.f;
#pragma unroll
  for (int ks = 0; ks < 8; ++ks) v += slab[((size_t)ks * TOK + tok) * 128 + col];
  return v;
}

template <bool WANT_Q>
DI void gla_prologue(int tid, const bf16_t* __restrict__ z, size_t tok0, int h, const float (&wu)[16], float ba,
                     float* qdT, float* kiT, float* alr, float* seg, float* Ed) {
  const int d_ = tid & 63, sg = tid >> 6;
  {
    const int t = tid >> 2, q4 = (tid & 3) * 4;
    const u32x2 av = *(const u32x2*)(z + (tok0 + t) * ABP + ZA + q4);
    *(f32x4*)(alr + t * 16 + q4) = (f32x4){lo2f(av[0]), hi2f(av[0]), lo2f(av[1]), hi2f(av[1])};
  }
  __syncthreads();
  float bb[16];
  {
    float run = 0.f;
#pragma unroll
    for (int i = 0; i < 16; ++i) {
      const int t = sg * 16 + i;
      float x = ba;
#pragma unroll
      for (int r = 0; r < 16; ++r) x += alr[t * 16 + r] * wu[r];
      const float ls = fminf(x, 0.f) - log1pf(__expf(-fabsf(x)));
      run += ls * (1.f / 16.f);
      bb[i] = run;
    }
    seg[sg * 64 + d_] = run;
  }
  __syncthreads();
  {
    float pre = 0.f, tot = 0.f;
#pragma unroll
    for (int s2 = 0; s2 < 4; ++s2) { const float v = seg[s2 * 64 + d_]; tot += v; if (s2 < sg) pre += v; }
    if (sg == 0) Ed[d_] = __expf(tot);
#pragma unroll
    for (int i = 0; i < 16; ++i) {
      const int t = sg * 16 + i;
      const float bt = bb[i] + pre;
      if (WANT_Q) qdT[d_ * 68 + t] = bf2f(z[(tok0 + t) * ABP + ZQ + h * 64 + d_]) * 0.125f * __expf(bt);
      kiT[d_ * 68 + t] = bf2f(z[(tok0 + t) * ABP + ZK + h * 64 + d_]) * __expf(-bt);
    }
  }
  __syncthreads();
}

DI void gla_pass2(float* __restrict__ Ubuf, const float* __restrict__ Ebuf) {
  const int idx = blockIdx.x * 256 + tidx();
  if (idx < 32 * 64 * 32) {
    const int bh = idx >> 11, d = (idx >> 5) & 63, v4 = idx & 31;
    f32x4 S = (f32x4){0.f, 0.f, 0.f, 0.f};
#pragma unroll 8
    for (int n = 0; n < 32; ++n) {
      float* p = Ubuf + (((size_t)bh * 32 + n) * 64 + d) * 128 + v4 * 4;
      const f32x4 u = *(const f32x4*)p;
      const float e = Ebuf[((size_t)bh * 32 + n) * 64 + d];
      *(f32x4*)p = S;
      S = e * (S + u);
    }
  }
}

DI void mla_prep(int first, int stride, const bf16_t* __restrict__ z, const float* __restrict__ qnw, const float* __restrict__ kvnw,
                         const int* __restrict__ pos, bf16_t* __restrict__ cqn, bf16_t* __restrict__ ckvn, bf16_t* __restrict__ krope,
                         const float* __restrict__ slab, const float* __restrict__ rowss) {
  const int tid = tidx(), lane = tid & 63, wv = tid >> 6;
  for (int tok = first * 4 + wv; tok < TOK; tok += stride * 4) {
    const bf16_t* zr = z + (size_t)tok * ABP;
    const float rsc = row_rsc(rowss, tok);
#pragma unroll
    for (int part = 0; part < 2; ++part) {
      const uint4 v = *(const uint4*)(zr + (part ? ZCKV : ZCQ) + lane * 8);
      float x[8] = {lo2f(v.x), hi2f(v.x), lo2f(v.y), hi2f(v.y), lo2f(v.z), hi2f(v.z), lo2f(v.w), hi2f(v.w)};
      if (part == 1 && lane >= 62) {
#pragma unroll
        for (int e = 0; e < 8; ++e) x[e] = slab_sum(slab, tok, (lane - 62) * 8 + e) * rsc;
      }
      float ss = 0.f;
#pragma unroll
      for (int e = 0; e < 8; ++e) ss += x[e] * x[e];
      ss = wave_sum(ss);
      const float r = rsqrtf(ss * (1.f / 512.f) + 1e-6f);
      const float* w = (part ? kvnw : qnw) + lane * 8;
      uint4 o;
      o.x = pack2(x[0] * r * w[0], x[1] * r * w[1]); o.y = pack2(x[2] * r * w[2], x[3] * r * w[3]);
      o.z = pack2(x[4] * r * w[4], x[5] * r * w[5]); o.w = pack2(x[6] * r * w[6], x[7] * r * w[7]);
      *(uint4*)((part ? ckvn : cqn) + (size_t)tok * 512 + lane * 8) = o;
    }
    if (lane < 32) {
      float c, s; rope_cs(pos[tok], lane, 13.287712379549449f / 32.f, c, s);
      const float x1 = slab_sum(slab, tok, 16 + lane) * rsc, x2 = slab_sum(slab, tok, 48 + lane) * rsc;
      krope[(size_t)tok * 64 + lane] = f2bf(x1 * c - x2 * s);
      krope[(size_t)tok * 64 + 32 + lane] = f2bf(x2 * c + x1 * s);
    }
  }
}

DI void gla_post(const float* __restrict__ ogla, const bf16_t* __restrict__ z, const float* __restrict__ gw, bf16_t* __restrict__ mix) {
  const int tid = tidx(), lane = tid & 63, wv = tid >> 6;
  for (int tok = blockIdx.x * 4 + wv; tok < TOK; tok += gridDim.x * 4) {
    float x[16];
#pragma unroll
    for (int i = 0; i < 4; ++i) { const float4 v = *(const float4*)(ogla + (size_t)tok * 1024 + lane * 16 + i * 4); x[4 * i] = v.x; x[4 * i + 1] = v.y; x[4 * i + 2] = v.z; x[4 * i + 3] = v.w; }
    float ss = 0.f;
#pragma unroll
    for (int e = 0; e < 16; ++e) ss += x[e] * x[e];
    ss += __shfl_xor(ss, 1); ss += __shfl_xor(ss, 2); ss += __shfl_xor(ss, 4);
    const float r = rsqrtf(ss * (1.f / 128.f) + 1e-6f);
    const uint4 g0 = *(const uint4*)(z + (size_t)tok * ABP + ZG + lane * 16);
    const uint4 g1 = *(const uint4*)(z + (size_t)tok * ABP + ZG + lane * 16 + 8);
    const float gg[16] = {lo2f(g0.x), hi2f(g0.x), lo2f(g0.y), hi2f(g0.y), lo2f(g0.z), hi2f(g0.z), lo2f(g0.w), hi2f(g0.w),
                          lo2f(g1.x), hi2f(g1.x), lo2f(g1.y), hi2f(g1.y), lo2f(g1.z), hi2f(g1.z), lo2f(g1.w), hi2f(g1.w)};
    const float* w = gw + (lane & 7) * 16;
    float y[16];
#pragma unroll
    for (int e = 0; e < 16; ++e) y[e] = x[e] * r * w[e] * (gg[e] * sigmoidf_(gg[e]));
    uint4 o0, o1;
    o0.x = pack2(y[0], y[1]); o0.y = pack2(y[2], y[3]); o0.z = pack2(y[4], y[5]); o0.w = pack2(y[6], y[7]);
    o1.x = pack2(y[8], y[9]); o1.y = pack2(y[10], y[11]); o1.z = pack2(y[12], y[13]); o1.w = pack2(y[14], y[15]);
    *(uint4*)(mix + (size_t)tok * DM + lane * 16) = o0;
    *(uint4*)(mix + (size_t)tok * DM + lane * 16 + 8) = o1;
  }
}

DI int koff(int row, int chunk) { return row * 256 + ((chunk ^ (row & 15)) << 4); }
DI int k2off(int row, int chunk) { return row * 128 + ((chunk ^ ((row >> 1) & 7)) << 4); }
DI int voff(int row, int chunk) { return row * 256 + ((((chunk >> 1) ^ (row & 7)) << 5) | ((chunk & 1) << 4)); }

DI void ldg_tile(int tid, const bf16_t* __restrict__ g, int ld, u32x4 (&r)[4]) {
#pragma unroll
  for (int i = 0; i < 4; ++i) { const int idx = tid + 256 * i, row = idx >> 4, ch = idx & 15; r[i] = *(const u32x4*)(g + (size_t)row * ld + ch * 8); }
}
DI void sts_tile_k(int tid, const u32x4 (&r)[4], char* dst) {
#pragma unroll
  for (int i = 0; i < 4; ++i) { const int idx = tid + 256 * i, row = idx >> 4, ch = idx & 15; *(u32x4*)(dst + koff(row, ch)) = r[i]; }
}
DI void sts_tile_v(int tid, const u32x4 (&r)[4], char* dst) {
#pragma unroll
  for (int i = 0; i < 4; ++i) { const int idx = tid + 256 * i, row = idx >> 4, ch = idx & 15; *(u32x4*)(dst + voff(row, ch)) = r[i]; }
}
DI void ldg_tile_k2(int tid, const bf16_t* __restrict__ g, int ld, u32x4 (&r)[2]) {
#pragma unroll
  for (int i = 0; i < 2; ++i) { const int idx = tid + 256 * i, row = idx >> 3, ch = idx & 7; r[i] = *(const u32x4*)(g + (size_t)row * ld + ch * 8); }
}
DI void sts_tile_k2(int tid, const u32x4 (&r)[2], char* dst) {
#pragma unroll
  for (int i = 0; i < 2; ++i) { const int idx = tid + 256 * i, row = idx >> 3, ch = idx & 7; *(u32x4*)(dst + k2off(row, ch)) = r[i]; }
}
DI void load_tile_k(int tid, const bf16_t* __restrict__ g, int ld, char* dst) { u32x4 r[4]; ldg_tile(tid, g, ld, r); sts_tile_k(tid, r, dst); }
DI void load_tile_v(int tid, const bf16_t* __restrict__ g, int ld, char* dst) { u32x4 r[4]; ldg_tile(tid, g, ld, r); sts_tile_v(tid, r, dst); }
template <int NKS, int QS>
DI void qk_tile(const char* Ks, const bf16x8 (&qf)[QS][6], int ks0, f32x4 (&s)[4][QS], int lane) {
#pragma unroll
  for (int ks = 0; ks < NKS; ++ks)
#pragma unroll
    for (int kt = 0; kt < 4; ++kt) {
      const bf16x8 kf = *(const bf16x8*)(Ks + koff(kt * 16 + (lane & 15), ks * 4 + (lane >> 4)));
#pragma unroll
      for (int qs = 0; qs < QS; ++qs) s[kt][qs] = __builtin_amdgcn_mfma_f32_16x16x32_bf16(kf, qf[qs][ks0 + ks], s[kt][qs], 0, 0, 0);
    }
}
template <int QS>
DI void qk_tile2(const char* K2s, const bf16x8 (&qf)[QS][6], f32x4 (&s)[4][QS], int lane) {
#pragma unroll
  for (int ks = 0; ks < 2; ++ks)
#pragma unroll
    for (int kt = 0; kt < 4; ++kt) {
      const bf16x8 kf = *(const bf16x8*)(K2s + k2off(kt * 16 + (lane & 15), ks * 4 + (lane >> 4)));
#pragma unroll
      for (int qs = 0; qs < QS; ++qs) s[kt][qs] = __builtin_amdgcn_mfma_f32_16x16x32_bf16(kf, qf[qs][4 + ks], s[kt][qs], 0, 0, 0);
    }
}
template <int QS>
DI void pv_tile(const char* Vs, const f32x4 (&s)[4][QS], f32x4 (&o)[QS][8], int lane) {
  const int g = lane >> 4, i = lane & 15;
#pragma unroll
  for (int c = 0; c < 2; ++c) {
    bf16x8 pf[QS];
#pragma unroll
    for (int qs = 0; qs < QS; ++qs) {
      union { uint4 u; bf16x8 v; } cv;
      cv.u.x = pack2(s[2 * c][qs][0], s[2 * c][qs][1]); cv.u.y = pack2(s[2 * c][qs][2], s[2 * c][qs][3]);
      cv.u.z = pack2(s[2 * c + 1][qs][0], s[2 * c + 1][qs][1]); cv.u.w = pack2(s[2 * c + 1][qs][2], s[2 * c + 1][qs][3]);
      pf[qs] = cv.v;
    }
    const int r1 = 32 * c + 4 * g + (i >> 2), r2 = r1 + 16;
#pragma unroll
    for (int dt = 0; dt < 8; ++dt) {
      const s16x4 lo = __builtin_amdgcn_ds_read_tr16_b64_v4i16(LDSP(s16x4, Vs + r1 * 256 + ((dt ^ (r1 & 7)) << 5) + 8 * (i & 3)));
      const s16x4 hi = __builtin_amdgcn_ds_read_tr16_b64_v4i16(LDSP(s16x4, Vs + r2 * 256 + ((dt ^ (r2 & 7)) << 5) + 8 * (i & 3)));
      bf16x8 vf; vf[0] = lo[0]; vf[1] = lo[1]; vf[2] = lo[2]; vf[3] = lo[3]; vf[4] = hi[0]; vf[5] = hi[1]; vf[6] = hi[2]; vf[7] = hi[3];
#pragma unroll
      for (int qs = 0; qs < QS; ++qs) o[qs][dt] = __builtin_amdgcn_mfma_f32_16x16x32_bf16(vf, pf[qs], o[qs][dt], 0, 0, 0);
    }
  }
}

enum { AM_MLA = 0, AM_WIN = 1, AM_SEL = 2 };
template <int MODE, int QS>
DI void softmax_tile(f32x4 (&s)[4][QS], f32x4 (&o)[QS][8], float (&m)[QS], float (&l)[QS], const int (&qi)[QS], const unsigned (&qmask)[QS],
                     int kbase, int tilebit, float sc, int lane, bool interior) {
  const int g = lane >> 4;
#pragma unroll
  for (int qs = 0; qs < QS; ++qs) {
    float mx = -1e30f;
    if (interior) {
      float sce = sc, bias = 0.f;
      if (MODE == AM_SEL) { const bool on = (qmask[qs] >> tilebit) & 1u; sce = on ? sc : 0.f; bias = on ? 0.f : -1e30f; }
#pragma unroll
      for (int kt = 0; kt < 4; ++kt)
#pragma unroll
        for (int r = 0; r < 4; ++r) { const float x = fmaf(s[kt][qs][r], sce, bias); s[kt][qs][r] = x; mx = fmaxf(mx, x); }
    } else {
#pragma unroll
      for (int kt = 0; kt < 4; ++kt)
#pragma unroll
        for (int r = 0; r < 4; ++r) {
          const int kj = kbase + kt * 16 + 4 * g + r;
          bool v = kj <= qi[qs];
          if (MODE == AM_WIN) v = v && (kj > qi[qs] - 512);
          if (MODE == AM_SEL) v = v && ((qmask[qs] >> tilebit) & 1u);
          const float x = v ? s[kt][qs][r] * sc : -1e30f;
          s[kt][qs][r] = x;
          mx = fmaxf(mx, x);
        }
    }
    mx = fmaxf(mx, __shfl_xor(mx, 16)); mx = fmaxf(mx, __shfl_xor(mx, 32));
    const bool keep = __all(mx - m[qs] <= 11.5416f);
    const float mn = keep ? m[qs] : fmaxf(m[qs], mx);
    const float alpha = keep ? 1.f : __builtin_amdgcn_exp2f(m[qs] - mn);
    m[qs] = mn;
    const float mnc = fmaxf(mn, -1e20f);
    float ps = 0.f;
#pragma unroll
    for (int kt = 0; kt < 4; ++kt)
#pragma unroll
      for (int r = 0; r < 4; ++r) { const float p = __builtin_amdgcn_exp2f(s[kt][qs][r] - mnc); s[kt][qs][r] = p; ps += p; }
    l[qs] = l[qs] * alpha + ps;
    if (!keep) {
#pragma unroll
      for (int dt = 0; dt < 8; ++dt) o[qs][dt] *= alpha;
    }
  }
}

template <int QS>
DI void mla_attn_item(int item, const bf16_t* __restrict__ q, const bf16_t* __restrict__ kv, const bf16_t* __restrict__ krope,
                              const int* __restrict__ pos, bf16_t* __restrict__ mix, char* smem) {
  const int tid = tidx(), lane = tid & 63, wave = tid >> 6, g = lane >> 4, i16 = lane & 15;
  const int qt = (NQT - 1) - (item >> 5), bh = item & 31, b = bh >> 3, h = bh & 7;
  const int q0 = qt * QB;
  const size_t tb = (size_t)b * SEQ;
  char* Ks = smem; char* Vs = smem + 16384; char* K2s = smem + 32768;
  bf16x8 qf[QS][6]; int qi[QS]; unsigned qm[QS] = {};
#pragma unroll
  for (int qs = 0; qs < QS; ++qs) {
    qi[qs] = q0 + wave * (16 * QS) + qs * 16 + i16;
    const bf16_t* qp = q + (tb + qi[qs]) * 1536 + h * 192;
#pragma unroll
    for (int ks = 0; ks < 6; ++ks) qf[qs][ks] = *(const bf16x8*)(qp + ks * 32 + g * 8);
    const int p = pos[tb + qi[qs]];
#pragma unroll
    for (int j = 0; j < 8; ++j) {
      float c, s; rope_cs(p, 8 * g + j, 13.287712379549449f / 32.f, c, s);
      const float x1 = bf2f((bf16_t)qf[qs][4][j]), x2 = bf2f((bf16_t)qf[qs][5][j]);
      qf[qs][4][j] = (short)f2bf(x1 * c - x2 * s);
      qf[qs][5][j] = (short)f2bf(x2 * c + x1 * s);
    }
  }
  f32x4 o[QS][8];
#pragma unroll
  for (int qs = 0; qs < QS; ++qs)
#pragma unroll
    for (int dt = 0; dt < 8; ++dt) o[qs][dt] = (f32x4){0.f, 0.f, 0.f, 0.f};
  float m[QS], l[QS];
#pragma unroll
  for (int qs = 0; qs < QS; ++qs) { m[qs] = -1e30f; l[qs] = 0.f; }
  const float sc = 0.07216878364870322f * 1.4426950408889634f;
  const int ntile = (qt + 1) * QS;
#pragma unroll 1
  for (int j = 0; j < ntile; ++j) {
    __syncthreads();
    load_tile_k(tid, kv + (tb + j * 64) * 2048 + h * 256, 2048, Ks);
    load_tile_v(tid, kv + (tb + j * 64) * 2048 + h * 256 + 128, 2048, Vs);
    { u32x4 r2[2]; ldg_tile_k2(tid, krope + (tb + j * 64) * 64, 64, r2); sts_tile_k2(tid, r2, K2s); }
    __syncthreads();
    f32x4 s[4][QS];
#pragma unroll
    for (int kt = 0; kt < 4; ++kt)
#pragma unroll
      for (int qs = 0; qs < QS; ++qs) s[kt][qs] = (f32x4){0.f, 0.f, 0.f, 0.f};
    qk_tile<4, QS>(Ks, qf, 0, s, lane);
    qk_tile2<QS>(K2s, qf, s, lane);
    softmax_tile<AM_MLA, QS>(s, o, m, l, qi, qm, j * 64, 0, sc, lane, j * 64 + 63 <= q0);
    pv_tile<QS>(Vs, s, o, lane);
  }
#pragma unroll
  for (int qs = 0; qs < QS; ++qs) {
    float lt = l[qs]; lt += __shfl_xor(lt, 16); lt += __shfl_xor(lt, 32);
    const float inv = lt > 0.f ? 1.f / lt : 0.f;
    bf16_t* op = mix + (tb + qi[qs]) * DM + 1024 + h * 128;
#pragma unroll
    for (int dt = 0; dt < 8; ++dt) {
      uint2 w; w.x = pack2(o[qs][dt][0] * inv, o[qs][dt][1] * inv); w.y = pack2(o[qs][dt][2] * inv, o[qs][dt][3] * inv);
      *(uint2*)(op + dt * 16 + 4 * g) = w;
    }
  }
}

DI void gla_pass1(int item, const bf16_t* __restrict__ z, const float* __restrict__ w_up, const float* __restrict__ b_alpha,
                  float* __restrict__ Ubuf, float* __restrict__ Ebuf, char* smem) {
  const int tid = tidx(), lane = tid & 63, wave = tid >> 6, g = lane >> 4;
  const int b = item >> 8, h = (item >> 5) & 7, n = item & 31;
  float* kiT = (float*)smem;
  char* Vs = (char*)(kiT + 64 * 68);
  float* alr = (float*)(Vs + 16384);
  float* seg = alr + 64 * 16;
  float* Ed = seg + 256;
  float wu[16];
#pragma unroll
  for (int r = 0; r < 16; ++r) wu[r] = w_up[r * 512 + h * 64 + (tid & 63)];
  const float ba = b_alpha[h * 64 + (tid & 63)];
  const size_t tok0 = (size_t)b * SEQ + n * 64;
  __syncthreads();
  load_tile_v(tid, z + tok0 * ABP + ZV + h * 128, ABP, Vs);
  gla_prologue<false>(tid, z, tok0, h, wu, ba, nullptr, kiT, alr, seg, Ed);
  const int dq = wave * 16 + (lane & 15);
  f32x4 sk[4][1], o[1][8];
#pragma unroll
  for (int kt = 0; kt < 4; ++kt) sk[kt][0] = *(const f32x4*)(kiT + dq * 68 + kt * 16 + 4 * g);
#pragma unroll
  for (int dt = 0; dt < 8; ++dt) o[0][dt] = zero4();
  pv_tile<1>(Vs, sk, o, lane);
  float* up = Ubuf + ((size_t)item * 64 + dq) * 128 + 4 * g;
#pragma unroll
  for (int dt = 0; dt < 8; ++dt) *(f32x4*)(up + dt * 16) = o[0][dt];
  if (g == 0) Ebuf[(size_t)item * 64 + dq] = Ed[dq];
}

DI void gla_pass3(int item, const bf16_t* __restrict__ z, const float* __restrict__ w_up, const float* __restrict__ b_alpha,
                  const float* __restrict__ Sbuf, const float* __restrict__ gw, bf16_t* __restrict__ mix, char* smem) {
  const int tid = tidx(), lane = tid & 63, wave = tid >> 6, g = lane >> 4;
  const int b = item >> 8, h = (item >> 5) & 7, n = item & 31;
  float* qdT = (float*)smem;
  float* kiT = qdT + 64 * 68;
  char* Ss = (char*)(kiT + 64 * 68);
  float* alr = (float*)(Ss + 16384);
  float* seg = alr + 64 * 16;
  float* Ed = seg + 256;
  char* Vs = smem;
  float wu[16];
#pragma unroll
  for (int r = 0; r < 16; ++r) wu[r] = w_up[r * 512 + h * 64 + (tid & 63)];
  const float ba = b_alpha[h * 64 + (tid & 63)];
  const size_t tok0 = (size_t)b * SEQ + n * 64;
  __syncthreads();
  gla_prologue<true>(tid, z, tok0, h, wu, ba, qdT, kiT, alr, seg, Ed);
  const int iq = wave * 16 + (lane & 15);
  f32x4 sq[4][1];
  {
    const int ti = tid >> 4, tj = tid & 15;
    float a4[4][4];
#pragma unroll
    for (int i = 0; i < 4; ++i)
#pragma unroll
      for (int j = 0; j < 4; ++j) a4[i][j] = 0.f;
    if (tj <= ti) {
#pragma unroll 4
      for (int d = 0; d < 64; ++d) {
        const f32x4 qv = *(const f32x4*)(qdT + d * 68 + ti * 4);
        const f32x4 kv = *(const f32x4*)(kiT + d * 68 + tj * 4);
#pragma unroll
        for (int i = 0; i < 4; ++i)
#pragma unroll
          for (int j = 0; j < 4; ++j) a4[i][j] += qv[i] * kv[j];
      }
    }
#pragma unroll
    for (int kt = 0; kt < 4; ++kt)
#pragma unroll
      for (int r = 0; r < 4; ++r) sq[kt][0][r] = qdT[(kt * 16 + 4 * g + r) * 68 + iq];
    __syncthreads();
#pragma unroll
    for (int i = 0; i < 4; ++i) {
      f32x4 o;
#pragma unroll
      for (int j = 0; j < 4; ++j) o[j] = (tj * 4 + j <= ti * 4 + i) ? a4[i][j] : 0.f;
      *(f32x4*)(kiT + (ti * 4 + i) * 68 + tj * 4) = o;
    }
  }
  load_tile_v(tid, z + tok0 * ABP + ZV + h * 128, ABP, Vs);
  {
    const float* Sg = Sbuf + (size_t)item * 64 * 128;
#pragma unroll
    for (int i = 0; i < 4; ++i) {
      const int idx = tid + 256 * i, row = idx >> 4, ch = idx & 15;
      const f32x4 x0 = *(const f32x4*)(Sg + row * 128 + ch * 8), x1 = *(const f32x4*)(Sg + row * 128 + ch * 8 + 4);
      u32x4 w; w[0] = pack2(x0[0], x0[1]); w[1] = pack2(x0[2], x0[3]); w[2] = pack2(x1[0], x1[1]); w[3] = pack2(x1[2], x1[3]);
      *(u32x4*)(Ss + voff(row, ch)) = w;
    }
  }
  __syncthreads();
  f32x4 o[1][8];
#pragma unroll
  for (int dt = 0; dt < 8; ++dt) o[0][dt] = (f32x4){0.f, 0.f, 0.f, 0.f};
  {
    f32x4 sa[4][1];
#pragma unroll
    for (int kt = 0; kt < 4; ++kt) sa[kt][0] = *(const f32x4*)(kiT + iq * 68 + kt * 16 + 4 * g);
    pv_tile<1>(Vs, sa, o, lane);
    pv_tile<1>(Ss, sq, o, lane);
  }
  {
    float ssq = 0.f;
#pragma unroll
    for (int dt = 0; dt < 8; ++dt) ssq += (o[0][dt][0] * o[0][dt][0] + o[0][dt][1] * o[0][dt][1]) + (o[0][dt][2] * o[0][dt][2] + o[0][dt][3] * o[0][dt][3]);
    ssq += __shfl_xor(ssq, 16); ssq += __shfl_xor(ssq, 32);
    const float r = rsqrtf(ssq * (1.f / 128.f) + 1e-6f);
#pragma unroll
    for (int dt = 0; dt < 8; ++dt) {
      const int dv = dt * 16 + 4 * g, col = h * 128 + dv;
      const u32x2 gq = *(const u32x2*)(z + (tok0 + iq) * ABP + ZG + col);
      const float gg[4] = {lo2f(gq[0]), hi2f(gq[0]), lo2f(gq[1]), hi2f(gq[1])};
      const f32x4 w = *(const f32x4*)(gw + dv);
      float y[4];
#pragma unroll
      for (int e = 0; e < 4; ++e) y[e] = o[0][dt][e] * r * w[e] * (gg[e] * sigmoidf_(gg[e]));
      u32x2 ov; ov[0] = pack2(y[0], y[1]); ov[1] = pack2(y[2], y[3]);
      *(u32x2*)(mix + (tok0 + iq) * DM + col) = ov;
    }
  }
}

DI void rope4(bf16_t* p1, const float (&c)[4], const float (&sn)[4], float (&y1)[4], float (&y2)[4]) {
  const u32x2 a = *(const u32x2*)p1, b = *(const u32x2*)(p1 + 64);
  const float x1[4] = {lo2f(a[0]), hi2f(a[0]), lo2f(a[1]), hi2f(a[1])}, x2[4] = {lo2f(b[0]), hi2f(b[0]), lo2f(b[1]), hi2f(b[1])};
#pragma unroll
  for (int e = 0; e < 4; ++e) { y1[e] = x1[e] * c[e] - x2[e] * sn[e]; y2[e] = x2[e] * c[e] + x1[e] * sn[e]; }
}
DI void st4bf(bf16_t* p, const float (&y)[4]) { u32x2 o; o[0] = pack2(y[0], y[1]); o[1] = pack2(y[2], y[3]); *(u32x2*)p = o; }
DI void nsa_prep(bf16_t* __restrict__ z, const int* __restrict__ pos, const float* __restrict__ cpos,
                 bf16_t* __restrict__ aflk, bf16_t* __restrict__ aflv, const float* __restrict__ slab, const float* __restrict__ rowss) {
  const int tid = tidx(), lane = tid & 63, wv = tid >> 6;
  for (int idx = blockIdx.x * 256 + tid; idx < 2 * 16 * 512; idx += gridDim.x * 256) {
    const int which = idx >> 13, r = idx & 8191, bg = r >> 9, ch = r & 511;
    *(u32x4*)((which ? aflv : aflk) + ((size_t)bg * 128 + 127) * 4096 + ch * 8) = (u32x4){0u, 0u, 0u, 0u};
  }
  const int hq = lane >> 4, d0 = (lane & 15) * 4;
  for (int tok = blockIdx.x * 4 + wv; tok < TOK; tok += gridDim.x * 4) {
    bf16_t* zr = z + (size_t)tok * NSP;
    const int b = tok >> 11, s = tok & 2047;
    if (lane < 48) zr[NGL + lane] = f2bf(slab_sum(slab, tok, lane) * row_rsc(rowss, tok));
    float c[4], sn[4];
    const int ps = pos[tok];
#pragma unroll
    for (int e = 0; e < 4; ++e) rope_cs(ps, d0 + e, 13.287712379549449f / 64.f, c[e], sn[e]);
    float y1[4], y2[4];
#pragma unroll
    for (int it = 0; it < 4; ++it) {
      bf16_t* p = zr + NQ + (it * 4 + hq) * 128 + d0;
      rope4(p, c, sn, y1, y2); st4bf(p, y1); st4bf(p + 64, y2);
    }
    { bf16_t* p = zr + NKS + hq * 128 + d0; rope4(p, c, sn, y1, y2); st4bf(p, y1); st4bf(p + 64, y2); }
    { bf16_t* p = zr + NKW + hq * 128 + d0; rope4(p, c, sn, y1, y2); st4bf(p, y1); st4bf(p + 64, y2); }
    rope4(zr + NKC + hq * 128 + d0, c, sn, y1, y2);
    float v1[4], v2[4];
    {
      const u32x2 a = *(const u32x2*)(zr + NVC + hq * 128 + d0), bq = *(const u32x2*)(zr + NVC + hq * 128 + 64 + d0);
      v1[0] = lo2f(a[0]); v1[1] = hi2f(a[0]); v1[2] = lo2f(a[1]); v1[3] = hi2f(a[1]);
      v2[0] = lo2f(bq[0]); v2[1] = hi2f(bq[0]); v2[2] = lo2f(bq[1]); v2[3] = hi2f(bq[1]);
    }
    const int n1 = s >> 4, l1 = s & 15;
    const size_t rb = (size_t)(b * 4 + hq) * 128;
#pragma unroll
    for (int w = 0; w < 2; ++w) {
      const int n = n1 - w, l = l1 + 16 * w;
      if (n >= 0 && n <= 126) {
        const size_t o = (rb + n) * 4096 + l * 128 + d0;
        const f32x4 pk1 = *(const f32x4*)(cpos + l * 128 + d0), pk2 = *(const f32x4*)(cpos + l * 128 + 64 + d0);
        const f32x4 pv1 = *(const f32x4*)(cpos + 4096 + l * 128 + d0), pv2 = *(const f32x4*)(cpos + 4096 + l * 128 + 64 + d0);
        const float a1[4] = {y1[0] + pk1[0], y1[1] + pk1[1], y1[2] + pk1[2], y1[3] + pk1[3]};
        const float a2[4] = {y2[0] + pk2[0], y2[1] + pk2[1], y2[2] + pk2[2], y2[3] + pk2[3]};
        const float b1[4] = {v1[0] + pv1[0], v1[1] + pv1[1], v1[2] + pv1[2], v1[3] + pv1[3]};
        const float b2[4] = {v2[0] + pv2[0], v2[1] + pv2[1], v2[2] + pv2[2], v2[3] + pv2[3]};
        st4bf(aflk + o, a1); st4bf(aflk + o + 64, a2);
        st4bf(aflv + o, b1); st4bf(aflv + o + 64, b2);
      }
    }
  }
}

template <int QS>
DI void load_q128(const bf16_t* __restrict__ z, size_t tb, int hh, int q0, int wave, int lane, bf16x8 (&qf)[QS][6], int (&qi)[QS]) {
#pragma unroll
  for (int qs = 0; qs < QS; ++qs) {
    qi[qs] = q0 + wave * (16 * QS) + qs * 16 + (lane & 15);
    const bf16_t* qp = z + (tb + qi[qs]) * NSP + NQ + hh * 128;
#pragma unroll
    for (int ks = 0; ks < 4; ++ks) qf[qs][ks] = *(const bf16x8*)(qp + ks * 32 + (lane >> 4) * 8);
    qf[qs][4] = qf[qs][0]; qf[qs][5] = qf[qs][0];
  }
}
DI float nsa_gate(const bf16_t* __restrict__ z, const float* __restrict__ bg, size_t tokrow, int hh, int c) {
  return sigmoidf_(bf2f(z[tokrow * NSP + NGL + hh * 3 + c]) + bg[hh * 3 + c]);
}

template <int QS>
DI void nsa_cmpwin_item(int item, const bf16_t* __restrict__ z, const bf16_t* __restrict__ kcmp, const bf16_t* __restrict__ vcmp,
                                const float* __restrict__ bgate, float* __restrict__ P, float* __restrict__ part, char* smem) {
  const int tid = tidx(), lane = tid & 63, wave = tid >> 6, g = lane >> 4;
  const int qt = item % NQT, hh = (item / NQT) & 15, b = item / (NQT * 16), grp = hh >> 2;
  const int q0 = qt * QB;
  const size_t tb = (size_t)b * SEQ;
  bf16x8 qf[QS][6]; int qi[QS]; unsigned qm[QS] = {};
  load_q128<QS>(z, tb, hh, q0, wave, lane, qf, qi);
  const float sc = 0.08838834764831845f * 1.4426950408889634f;
  f32x4 o[QS][8];
  {
    __syncthreads();
    const bf16_t* kc = kcmp + (size_t)(b * 4 + grp) * 128 * 128;
    const bf16_t* vc = vcmp + (size_t)(b * 4 + grp) * 128 * 128;
    load_tile_k(tid, kc, 128, smem); load_tile_k(tid, kc + 64 * 128, 128, smem + 16384);
    load_tile_v(tid, vc, 128, smem + 32768); load_tile_v(tid, vc + 64 * 128, 128, smem + 49152);
    __syncthreads();
    f32x4 s0[4][QS], s1[4][QS];
#pragma unroll
    for (int kt = 0; kt < 4; ++kt)
#pragma unroll
      for (int qs = 0; qs < QS; ++qs) { s0[kt][qs] = (f32x4){0.f, 0.f, 0.f, 0.f}; s1[kt][qs] = (f32x4){0.f, 0.f, 0.f, 0.f}; }
    qk_tile<4, QS>(smem, qf, 0, s0, lane);
    qk_tile<4, QS>(smem + 16384, qf, 0, s1, lane);
#pragma unroll
    for (int qs = 0; qs < QS; ++qs) {
      float mx = -1e30f;
#pragma unroll
      for (int kt = 0; kt < 4; ++kt)
#pragma unroll
        for (int r = 0; r < 4; ++r) {
          const int n = kt * 16 + 4 * g + r;
          const float x0 = (16 * n + 31 <= qi[qs]) ? s0[kt][qs][r] * sc : -1e30f;
          const float x1 = (16 * (n + 64) + 31 <= qi[qs]) ? s1[kt][qs][r] * sc : -1e30f;
          s0[kt][qs][r] = x0; s1[kt][qs][r] = x1; mx = fmaxf(mx, fmaxf(x0, x1));
        }
      mx = fmaxf(mx, __shfl_xor(mx, 16)); mx = fmaxf(mx, __shfl_xor(mx, 32));
      float ps = 0.f;
#pragma unroll
      for (int kt = 0; kt < 4; ++kt)
#pragma unroll
        for (int r = 0; r < 4; ++r) {
          const float p0 = s0[kt][qs][r] > -1e29f ? exp2f(s0[kt][qs][r] - mx) : 0.f;
          const float p1 = s1[kt][qs][r] > -1e29f ? exp2f(s1[kt][qs][r] - mx) : 0.f;
          s0[kt][qs][r] = p0; s1[kt][qs][r] = p1; ps += p0 + p1;
        }
      ps += __shfl_xor(ps, 16); ps += __shfl_xor(ps, 32);
      const float inv = ps > 0.f ? 1.f / ps : 0.f;
      float* pp = P + (((size_t)b * 16 + hh) * SEQ + qi[qs]) * 128;
#pragma unroll
      for (int kt = 0; kt < 4; ++kt) {
        s0[kt][qs] *= inv; s1[kt][qs] *= inv;
        *(f32x4*)(pp + kt * 16 + 4 * g) = s0[kt][qs];
        *(f32x4*)(pp + 64 + kt * 16 + 4 * g) = s1[kt][qs];
      }
    }
#pragma unroll
    for (int qs = 0; qs < QS; ++qs)
#pragma unroll
      for (int dt = 0; dt < 8; ++dt) o[qs][dt] = (f32x4){0.f, 0.f, 0.f, 0.f};
    pv_tile<QS>(smem + 32768, s0, o, lane);
    pv_tile<QS>(smem + 49152, s1, o, lane);
#pragma unroll
    for (int qs = 0; qs < QS; ++qs) {
      const float g0 = nsa_gate(z, bgate, tb + qi[qs], hh, 0);
      float* op = part + (tb + qi[qs]) * DM + hh * 128;
#pragma unroll
      for (int dt = 0; dt < 8; ++dt) *(f32x4*)(op + dt * 16 + 4 * g) = o[qs][dt] * g0;
    }
  }
  {
    char* Ks = smem; char* Vs = smem + 16384;
#pragma unroll
    for (int qs = 0; qs < QS; ++qs)
#pragma unroll
      for (int dt = 0; dt < 8; ++dt) o[qs][dt] = (f32x4){0.f, 0.f, 0.f, 0.f};
    float m[QS], l[QS];
#pragma unroll
  for (int qs = 0; qs < QS; ++qs) { m[qs] = -1e30f; l[qs] = 0.f; }
    const int j0 = (qt * QS - 8) > 0 ? (qt * QS - 8) : 0, j1 = qt * QS + QS - 1;
#pragma unroll 1
    for (int j = j0; j <= j1; ++j) {
      __syncthreads();
      load_tile_k(tid, z + (tb + j * 64) * NSP + NKW + grp * 128, NSP, Ks);
      load_tile_v(tid, z + (tb + j * 64) * NSP + NVW + grp * 128, NSP, Vs);
      __syncthreads();
      f32x4 s[4][QS];
#pragma unroll
      for (int kt = 0; kt < 4; ++kt)
#pragma unroll
        for (int qs = 0; qs < QS; ++qs) s[kt][qs] = (f32x4){0.f, 0.f, 0.f, 0.f};
      qk_tile<4, QS>(Ks, qf, 0, s, lane);
      softmax_tile<AM_WIN, QS>(s, o, m, l, qi, qm, j * 64, 0, sc, lane, (j * 64 + 63 <= q0) && (j * 64 > q0 + QB - 1 - 512));
      pv_tile<QS>(Vs, s, o, lane);
    }
#pragma unroll
    for (int qs = 0; qs < QS; ++qs) {
      float lt = l[qs]; lt += __shfl_xor(lt, 16); lt += __shfl_xor(lt, 32);
      const float inv = (lt > 0.f ? 1.f / lt : 0.f) * nsa_gate(z, bgate, tb + qi[qs], hh, 2);
      float* op = part + (tb + qi[qs]) * DM + hh * 128;
#pragma unroll
      for (int dt = 0; dt < 8; ++dt) { f32x4 pv = *(f32x4*)(op + dt * 16 + 4 * g); pv += o[qs][dt] * inv; *(f32x4*)(op + dt * 16 + 4 * g) = pv; }
    }
  }
}

DI void nsa_select(const float* __restrict__ P, unsigned* __restrict__ sel) {
  const int tid = tidx(), lane = tid & 63, wv = tid >> 6, m = lane & 31, half = lane >> 5;
  for (int base = (blockIdx.x * 4 + wv) * 2; base < 16 * SEQ; base += gridDim.x * 8) {
    const int idx = base + half;
    const int bg = idx >> 11, s = idx & 2047, b = bg >> 2, grp = bg & 3;
    float imp = 0.f, lastv = 0.f;
#pragma unroll
    for (int j = 0; j < 4; ++j) {
      const f32x4 pv = *(const f32x4*)(P + (((size_t)b * 16 + grp * 4 + j) * SEQ + s) * 128 + 4 * m);
      imp += (pv[0] + pv[1]) + (pv[2] + pv[3]);
      lastv += pv[3];
    }
    {
      const float prevl = __shfl(lastv, half * 32 + ((m + 31) & 31));
      if (m >= 1) imp += prevl;
    }
    const int cur = s >> 6;
    const bool cand = (m >= 1) && (m <= cur - 2);
    int rank = 0;
    for (int mm = 0; mm < 32; ++mm) {
      const float v = __shfl(imp, half * 32 + mm);
      const bool c2 = (mm >= 1) && (mm <= cur - 2);
      if (c2 && (v > imp || (v == imp && mm < m))) ++rank;
    }
    bool selb;
    if (cur <= 15) selb = (m <= cur);
    else selb = (m == 0) || (m == cur) || (m == cur - 1) || (cand && rank < 13);
    const unsigned long long bal = __ballot(selb);
    const unsigned mk = half ? (unsigned)(bal >> 32) : (unsigned)(bal & 0xffffffffull);
    if (m == 0) sel[idx] = mk;
  }
}

template <int QS>
DI void nsa_sel_item(int item, const bf16_t* __restrict__ z, const unsigned* __restrict__ sel, const float* __restrict__ bgate,
                             const float* __restrict__ part, bf16_t* __restrict__ mix, char* smem) {
  const int tid = tidx(), lane = tid & 63, wave = tid >> 6, g = lane >> 4;
  const int qt = (NQT - 1) - (item >> 6), bh = item & 63, b = bh >> 4, hh = bh & 15, grp = hh >> 2;
  const int q0 = qt * QB;
  const size_t tb = (size_t)b * SEQ;
  bf16x8 qf[QS][6]; int qi[QS]; unsigned qm[QS];
  load_q128<QS>(z, tb, hh, q0, wave, lane, qf, qi);
  unsigned um = 0u;
#pragma unroll
  for (int qs = 0; qs < QS; ++qs) { qm[qs] = sel[(size_t)(b * 4 + grp) * SEQ + qi[qs]]; um |= qm[qs]; }
#pragma unroll
  for (int o2 = 1; o2 < 16; o2 <<= 1) um |= __shfl_xor(um, o2);
  unsigned* ush = (unsigned*)(smem + 40960);
  __syncthreads();
  if (lane == 0) ush[wave] = um;
  __syncthreads();
  um = ush[0] | ush[1] | ush[2] | ush[3];
  const float sc = 0.08838834764831845f * 1.4426950408889634f;
  char* Ks = smem; char* Vs = smem + 16384;
  f32x4 o[QS][8];
#pragma unroll
  for (int qs = 0; qs < QS; ++qs)
#pragma unroll
    for (int dt = 0; dt < 8; ++dt) o[qs][dt] = (f32x4){0.f, 0.f, 0.f, 0.f};
  float m[QS], l[QS];
#pragma unroll
  for (int qs = 0; qs < QS; ++qs) { m[qs] = -1e30f; l[qs] = 0.f; }
  const int j1 = qt * QS + QS - 1;
  unsigned rem = um & ((j1 >= 31) ? 0xffffffffu : ((2u << j1) - 1u));
#pragma unroll 1
  while (rem) {
    const int j = __builtin_ctz(rem);
    rem &= rem - 1u;
    __syncthreads();
    load_tile_k(tid, z + (tb + j * 64) * NSP + NKS + grp * 128, NSP, Ks);
    load_tile_v(tid, z + (tb + j * 64) * NSP + NVS + grp * 128, NSP, Vs);
    __syncthreads();
    f32x4 s[4][QS];
#pragma unroll
    for (int kt = 0; kt < 4; ++kt)
#pragma unroll
      for (int qs = 0; qs < QS; ++qs) s[kt][qs] = (f32x4){0.f, 0.f, 0.f, 0.f};
    qk_tile<4, QS>(Ks, qf, 0, s, lane);
    softmax_tile<AM_SEL, QS>(s, o, m, l, qi, qm, j * 64, j, sc, lane, j * 64 + 63 <= q0);
    pv_tile<QS>(Vs, s, o, lane);
  }
#pragma unroll
  for (int qs = 0; qs < QS; ++qs) {
    float lt = l[qs]; lt += __shfl_xor(lt, 16); lt += __shfl_xor(lt, 32);
    const float inv = (lt > 0.f ? 1.f / lt : 0.f) * nsa_gate(z, bgate, tb + qi[qs], hh, 1);
    const float* pp = part + (tb + qi[qs]) * DM + hh * 128;
    bf16_t* op = mix + (tb + qi[qs]) * DM + hh * 128;
#pragma unroll
    for (int dt = 0; dt < 8; ++dt) {
      const f32x4 pv = *(const f32x4*)(pp + dt * 16 + 4 * g);
      uint2 w; w.x = pack2(pv[0] + o[qs][dt][0] * inv, pv[1] + o[qs][dt][1] * inv); w.y = pack2(pv[2] + o[qs][dt][2] * inv, pv[3] + o[qs][dt][3] * inv);
      *(uint2*)(op + dt * 16 + 4 * g) = w;
    }
  }
}


#define XB_TMO      128
#define XB_XCNT(j)  (256  + 64 * (j))
#define XB_XSUB(j)  (1280 + 64 * (j))
#define XB_XGEN(j)  (2304 + 64 * (j))
#define XB_TOP      3328
#define XB_TOPGEN   3392
#define XCD_BAR_WORDS 3456
#define XB_SPIN_CAP (1u << 20)
#define LAS __attribute__((address_space(3)))
DI unsigned xb_ld(unsigned* p)              { return __hip_atomic_load(p, __ATOMIC_RELAXED, __HIP_MEMORY_SCOPE_AGENT); }
DI unsigned xb_add(unsigned* p, unsigned v) { return __hip_atomic_fetch_add(p, v, __ATOMIC_RELAXED, __HIP_MEMORY_SCOPE_AGENT); }
DI unsigned xb_xcc_id() { return (unsigned)__builtin_amdgcn_s_getreg((3 << 11) | 20) & 0xFu; }
#define XB_SPIN(cond, bar) do { unsigned _sp = 0; while (cond) { __builtin_amdgcn_s_sleep(1); \
    if ((++_sp & 255u) == 0u) { if (xb_ld(&(bar)[XB_TMO])) break; if (_sp > XB_SPIN_CAP) { atomicAdd(&(bar)[XB_TMO], 1u); break; } } } } while (0)
struct XcdBarrier { unsigned* bar; unsigned x; volatile LAS unsigned* st; };
DI XcdBarrier xcd_barrier_post(unsigned* bar, volatile LAS unsigned* st) {
  XcdBarrier b; b.bar = bar; b.x = xb_xcc_id(); b.st = st;
  if (threadIdx.x == 0) (void)xb_add(&bar[XB_XCNT(b.x)], 1u);
  return b;
}
DI void xcd_barrier_complete(unsigned* bar, unsigned x, unsigned& nloc, unsigned& nx) {
  const unsigned G = gridDim.x * gridDim.y * gridDim.z;
  unsigned sum, cnt, mine, sp = 0u;
  for (;;) {
    sum = 0u; cnt = 0u; mine = 0u;
#pragma unroll
    for (unsigned j = 0; j < 16; ++j) { const unsigned c = xb_ld(&bar[XB_XCNT(j)]); sum += c; cnt += (c > 0u) ? 1u : 0u; mine = (j == x) ? c : mine; }
    if (sum == G) break;
    __builtin_amdgcn_s_sleep(1);
    if ((++sp & 255u) == 0u) { if (xb_ld(&bar[XB_TMO])) break; if (sp > XB_SPIN_CAP) { atomicAdd(&bar[XB_TMO], 1u); break; } }
  }
  nloc = mine > 0u ? mine : 1u; nx = cnt > 0u ? cnt : 1u;
}
DI void xcd_barrier(const XcdBarrier& b) {
  asm volatile("s_waitcnt vmcnt(0)" ::: "memory");
  __syncthreads();
  if (threadIdx.x == 0) {
    unsigned* bar = b.bar;
    __builtin_amdgcn_s_waitcnt(0);
    unsigned nloc = b.st[0], nx = b.st[1];
    if (nloc == 0u) { xcd_barrier_complete(bar, b.x, nloc, nx); b.st[0] = nloc; b.st[1] = nx; }
    const unsigned old = xb_add(&bar[XB_XSUB(b.x)], 1u);
    const unsigned gen = old / nloc;
    if (old + 1u == (gen + 1u) * nloc) {
      __builtin_amdgcn_fence(__ATOMIC_RELEASE, "agent");
      asm volatile("s_waitcnt vmcnt(0)" ::: "memory");
      const unsigned og = xb_add(&bar[XB_TOP], 1u);
      const unsigned tg = og / nx;
      if (og + 1u == (tg + 1u) * nx) xb_add(&bar[XB_TOPGEN], 1u);
      else XB_SPIN(xb_ld(&bar[XB_TOPGEN]) == tg, bar);
      __builtin_amdgcn_fence(__ATOMIC_ACQUIRE, "agent");
      xb_add(&bar[XB_XGEN(b.x)], 1u);
      asm volatile("s_waitcnt vmcnt(0)" ::: "memory");
    } else {
      XB_SPIN(xb_ld(&bar[XB_XGEN(b.x)]) == gen, bar);
      __builtin_amdgcn_fence(__ATOMIC_ACQUIRE, "agent");
      asm volatile("s_waitcnt vmcnt(0)" ::: "memory");
    }
  }
  __syncthreads();
}

DI void flat_barrier(unsigned* cnt, unsigned target) {
  asm volatile("s_waitcnt vmcnt(0)" ::: "memory");
  __syncthreads();
  if (threadIdx.x == 0) {
    __builtin_amdgcn_fence(__ATOMIC_RELEASE, "agent");
    asm volatile("s_waitcnt vmcnt(0)" ::: "memory");
    (void)xb_add(cnt, 1u);
    unsigned sp = 0u;
    while (xb_ld(cnt) < target) { __builtin_amdgcn_s_sleep(1); if (++sp > (1u << 24)) break; }
    __builtin_amdgcn_fence(__ATOMIC_ACQUIRE, "agent");
    asm volatile("s_waitcnt vmcnt(0)" ::: "memory");
  }
  __syncthreads();
}

DI void hier_barrier(unsigned* bar, volatile LAS unsigned* st) {
  asm volatile("s_waitcnt vmcnt(0)" ::: "memory");
  __syncthreads();
  if (threadIdx.x == 0) {
    const unsigned x = blockIdx.x & 7u;
    __builtin_amdgcn_fence(__ATOMIC_RELEASE, "agent");
    asm volatile("s_waitcnt vmcnt(0)" ::: "memory");
    unsigned nloc = st[0], nx = st[1];
    if (nloc == 0u) { xcd_barrier_complete(bar, x, nloc, nx); st[0] = nloc; st[1] = nx; }
    const unsigned old = xb_add(&bar[XB_XSUB(x)], 1u);
    const unsigned gen = old / nloc;
    if (old + 1u == (gen + 1u) * nloc) {
      const unsigned og = xb_add(&bar[XB_TOP], 1u);
      const unsigned tg = og / nx;
      if (og + 1u == (tg + 1u) * nx) xb_add(&bar[XB_TOPGEN], 1u);
      else XB_SPIN(xb_ld(&bar[XB_TOPGEN]) == tg, bar);
      xb_add(&bar[XB_XGEN(x)], 1u);
    } else {
      XB_SPIN(xb_ld(&bar[XB_XGEN(x)]) == gen, bar);
    }
    __builtin_amdgcn_fence(__ATOMIC_ACQUIRE, "agent");
    asm volatile("s_waitcnt vmcnt(0)" ::: "memory");
  }
  __syncthreads();
}

__global__ void __launch_bounds__(256, 2) mega(Params p) {
  cg::grid_group grid = cg::this_grid();
  __shared__ __attribute__((aligned(16))) char smem[65536 + 16];
  char* ws = p.ws;
  if (threadIdx.x == 0) { *(unsigned*)(smem + 65536) = 0u; *(unsigned*)(smem + 65540) = 0u; }
  __syncthreads();
  const XcdBarrier xb = xcd_barrier_post((unsigned*)(ws + A_BAR), (volatile LAS unsigned*)LDSP(unsigned, smem + 65536));
  if (p.out == nullptr) grid.sync();
  const int* pos = (const int*)p.in[2];
  float* h = (float*)(ws + A_H);
  bf16_t* hn = (bf16_t*)(ws + A_HN);
  bf16_t* mix = (bf16_t*)(ws + A_MIX);
  float* mb = (float*)(ws + A_MB);
  float* rss = (float*)(ws + A_RSS);
  bf16_t* mbh = (bf16_t*)(ws + A_MB) + (size_t)TOK * DM;
  bf16_t* zb = (bf16_t*)(ws + A_R1);
  bf16_t* hid = (bf16_t*)(ws + A_R1);

  for (int j = 0; j < 2; ++j) {
    transpose_job(p.in[7] + (size_t)j * 2048 * ABN, 2048, ABN, ABP, (bf16_t*)(ws + W_ABIN) + (size_t)j * ABP * 2048, 0, smem);
    transpose_job(p.in[12] + (size_t)j * 512 * 1536, 512, 1536, 1536, (bf16_t*)(ws + W_UQ) + (size_t)j * 1536 * 512, 0, smem);
    transpose_job(p.in[14] + (size_t)j * 512 * 2048, 512, 2048, 2048, (bf16_t*)(ws + W_UKV) + (size_t)j * 2048 * 512, 0, smem);
    transpose_job(p.in[15] + (size_t)j * 2048 * 2048, 2048, 2048, 2048, (bf16_t*)(ws + W_ABOUT) + (size_t)j * 2048 * 2048, 0, smem);
    transpose_job(p.in[16] + (size_t)j * 2048 * NSN, 2048, NSN, NSP, (bf16_t*)(ws + W_NSIN) + (size_t)j * NSP * 2048, 0, smem);
    for (int kv = 0; kv < 2; ++kv) {
      transpose_job(p.in[19] + (size_t)(j * 2 + kv) * 4096 * 128, 4096, 128, 128, (bf16_t*)(ws + W_W1) + (size_t)(j * 2 + kv) * 128 * 4096, 0, smem);
      transpose_job(p.in[20] + (size_t)(j * 2 + kv) * 128 * 128, 128, 128, 128, (bf16_t*)(ws + W_W2) + (size_t)(j * 2 + kv) * 128 * 128, 0, smem);
    }
    transpose_job(p.in[21] + (size_t)j * 2048 * 2048, 2048, 2048, 2048, (bf16_t*)(ws + W_NSOUT) + (size_t)j * 2048 * 2048, 0, smem);
  }
  for (int i = 0; i < 4; ++i) {
    transpose_job(p.in[22] + (size_t)i * 2048 * FH, 2048, FH, FH, (bf16_t*)(ws + W_FGU) + (size_t)i * 11264 * 2048, 1, smem);
    transpose_job(p.in[23] + (size_t)i * 2048 * FH, 2048, FH, FH, (bf16_t*)(ws + W_FGU) + (size_t)i * 11264 * 2048, 2, smem);
    transpose_job(p.in[24] + (size_t)i * FH * 2048, FH, 2048, 2048, (bf16_t*)(ws + W_FD) + (size_t)i * 2048 * FH, 0, smem);
    transpose_job(p.in[25] + (size_t)i * 2048 * 2048, 2048, 2048, 2048, (bf16_t*)(ws + W_PG) + (size_t)i * 2048 * 2048, 0, smem);
    transpose_job(p.in[27] + (size_t)i * 256 * 2048, 256, 2048, 2048, (bf16_t*)(ws + W_PP) + (size_t)i * 2048 * 256, 0, smem);
  }
  {
    const float* pp = p.in[1]; bf16_t* pb = (bf16_t*)(ws + A_PBF);
    for (size_t i = (size_t)blockIdx.x * 256 + tidx(); i < (size_t)4 * TOK * 256 / 4; i += (size_t)gridDim.x * 256) {
      const f32x4 t4 = __builtin_nontemporal_load((const f32x4*)(pp + i * 4)); const float4 v = make_float4(t4[0], t4[1], t4[2], t4[3]);
      uint2 o; o.x = pack2(v.x, v.y); o.y = pack2(v.z, v.w);
      *(uint2*)(pb + i * 4) = o;
    }
  }
  row_pass(p.in[0], nullptr, nullptr, h, p.in[3], hn);
  xcd_barrier(xb);
  unsigned bepoch = 0u;

  for (int layer = 0; layer < 4; ++layer) {
    const int j = layer >> 1;
    GArgs ga{};
    if ((layer & 1) == 0) {
      ga = GArgs{}; ga.A = (layer == 0) ? hn : mix; ga.rowss = (layer == 0) ? nullptr : rss; ga.lda = DM; ga.Bt = (bf16_t*)(ws + W_ABIN) + (size_t)j * ABP * 2048; ga.K = 2048; ga.M = TOK; ga.Npad = 4096; ga.C = zb; ga.ldc = ABP;
      gemm_phase<EPI_BF16>(ga, smem);
      gemm_tail_splitk(ga.A, ga.Bt + (size_t)4096 * 2048, (float*)(ws + A_R3), smem);
      xcd_barrier(xb);
      bf16_t* cqn = (bf16_t*)(ws + A_R5); bf16_t* ckvn = cqn + (size_t)TOK * 512; bf16_t* krope = (bf16_t*)(ws + A_KR);
      float* ogla = (float*)(ws + A_R4);
      bf16_t* mq = (bf16_t*)(ws + A_R3); bf16_t* mkv = mq + (size_t)TOK * 1536;
      float* Ubuf = mb; float* Ebuf = mb + (size_t)10 * 1024 * 1024;
      for (int it = blockIdx.x; it < 1024; it += gridDim.x) gla_pass1(it, zb, p.in[8] + (size_t)j * 16 * 512, p.in[9] + (size_t)j * 512, Ubuf, Ebuf, smem);
      mla_prep(blockIdx.x, gridDim.x, zb, p.in[11] + j * 512, p.in[13] + j * 512, pos, cqn, ckvn, krope, (const float*)(ws + A_R3), (layer == 0) ? nullptr : rss);
      xcd_barrier(xb);
      gla_pass2(Ubuf, Ebuf);
      ga = GArgs{}; ga.A = cqn; ga.lda = 512; ga.Bt = (bf16_t*)(ws + W_UQ) + (size_t)j * 1536 * 512; ga.K = 512; ga.M = TOK; ga.Npad = 1536; ga.C = mq; ga.ldc = 1536;
      gemm_phase<EPI_BF16>(ga, smem);
      ga = GArgs{}; ga.A = ckvn; ga.lda = 512; ga.Bt = (bf16_t*)(ws + W_UKV) + (size_t)j * 2048 * 512; ga.K = 512; ga.M = TOK; ga.Npad = 2048; ga.C = mkv; ga.ldc = 2048;
      gemm_phase<EPI_BF16>(ga, smem);
      xcd_barrier(xb);
      for (int it = blockIdx.x; it < 1024; it += gridDim.x) gla_pass3(it, zb, p.in[8] + (size_t)j * 16 * 512, p.in[9] + (size_t)j * 512, Ubuf, p.in[10] + j * 128, mix, smem);
      {
        int r = 0;
        for (int base = 0; base < 32 * (SEQ / (64 * QS_MLA)); base += gridDim.x, ++r) {
          const int it = base + ((r & 1) ? (gridDim.x - 1 - blockIdx.x) : blockIdx.x);
          if (it < 32 * (SEQ / (64 * QS_MLA))) mla_attn_item<QS_MLA>(it, mq, mkv, krope, pos, mix, smem);
        }
      }
      xcd_barrier(xb);
      ga = GArgs{}; ga.A = mix; ga.lda = DM; ga.Bt = (bf16_t*)(ws + W_ABOUT) + (size_t)j * 2048 * 2048; ga.K = 2048; ga.M = TOK; ga.Npad = 2048; ga.C = mbh; ga.ldc = DM;
      gemm_phase<EPI_BF16>(ga, smem);
      xcd_barrier(xb);
    } else {
      ga = GArgs{}; ga.A = mix; ga.rowss = rss; ga.lda = DM; ga.Bt = (bf16_t*)(ws + W_NSIN) + (size_t)j * NSP * 2048; ga.K = 2048; ga.M = TOK; ga.Npad = 5120; ga.C = zb; ga.ldc = NSP;
      gemm_phase<EPI_BF16>(ga, smem);
      gemm_tail_splitk(ga.A, ga.Bt + (size_t)5120 * 2048, (float*)(ws + A_R3), smem);
      xcd_barrier(xb);
      bf16_t* aflk = (bf16_t*)(ws + A_R4); bf16_t* aflv = aflk + (size_t)2048 * 4096;
      bf16_t* hck = (bf16_t*)(ws + A_R5); bf16_t* hcv = hck + 2048 * 128; bf16_t* kcmp = hcv + 2048 * 128; bf16_t* vcmp = kcmp + 2048 * 128;
      float* P = (float*)(ws + A_R3);
      unsigned* sel = (unsigned*)(ws + A_SEL);
      const float* bgate = p.in[17] + j * 48;
      nsa_prep(zb, pos, p.in[18] + (size_t)j * 2 * 4096, aflk, aflv, (const float*)(ws + A_R3), rss);
      xcd_barrier(xb);
      ga = GArgs{}; ga.A = aflk; ga.lda = 4096; ga.Bt = (bf16_t*)(ws + W_W1) + (size_t)(j * 2) * 128 * 4096; ga.K = 4096; ga.M = 2048; ga.Npad = 128; ga.C = hck; ga.ldc = 128;
      gemm_phase<EPI_GELU>(ga, smem);
      ga.A = aflv; ga.Bt = (bf16_t*)(ws + W_W1) + (size_t)(j * 2 + 1) * 128 * 4096; ga.C = hcv;
      gemm_phase<EPI_GELU>(ga, smem);
      xcd_barrier(xb);
      ga = GArgs{}; ga.A = hck; ga.lda = 128; ga.Bt = (bf16_t*)(ws + W_W2) + (size_t)(j * 2) * 128 * 128; ga.K = 128; ga.M = 2048; ga.Npad = 128; ga.C = kcmp; ga.ldc = 128;
      gemm_phase<EPI_BF16>(ga, smem);
      ga.A = hcv; ga.Bt = (bf16_t*)(ws + W_W2) + (size_t)(j * 2 + 1) * 128 * 128; ga.C = vcmp;
      gemm_phase<EPI_BF16>(ga, smem);
      xcd_barrier(xb);
      for (int it = blockIdx.x; it < 64 * (SEQ / (64 * QS_CW)); it += gridDim.x) nsa_cmpwin_item<QS_CW>(it, zb, kcmp, vcmp, bgate, P, mb, smem);
      xcd_barrier(xb);
      nsa_select(P, sel);
      xcd_barrier(xb);
      {
        int r = 0;
        for (int base = 0; base < 64 * (SEQ / (64 * QS_SEL)); base += gridDim.x, ++r) {
          const int it = base + ((r & 1) ? (gridDim.x - 1 - blockIdx.x) : blockIdx.x);
          if (it < 64 * (SEQ / (64 * QS_SEL))) nsa_sel_item<QS_SEL>(it, zb, sel, bgate, mb, mix, smem);
        }
      }
      xcd_barrier(xb);
      ga = GArgs{}; ga.A = mix; ga.lda = DM; ga.Bt = (bf16_t*)(ws + W_NSOUT) + (size_t)j * 2048 * 2048; ga.K = 2048; ga.M = TOK; ga.Npad = 2048; ga.C = mbh; ga.ldc = DM;
      gemm_phase<EPI_BF16>(ga, smem);
      xcd_barrier(xb);
    }
    row_pass(nullptr, mbh, p.in[4] + layer * DM, h, p.in[5] + layer * DM, hn);
    xcd_barrier(xb);
    ga = GArgs{}; ga.A = hn; ga.lda = DM; ga.Bt = (bf16_t*)(ws + W_FGU) + (size_t)layer * 11264 * 2048; ga.K = 2048; ga.M = TOK; ga.Npad = 11264; ga.C = hid; ga.ldc = FH;
    gemm_phase<EPI_SWIGLU>(ga, smem);
    xcd_barrier(xb);
    ga = GArgs{}; ga.A = hid; ga.lda = FH; ga.Bt = (bf16_t*)(ws + W_FD) + (size_t)layer * 2048 * FH; ga.K = FH; ga.M = TOK; ga.Npad = 2048; ga.C = mbh; ga.ldc = DM;
    gemm_phase<EPI_BF16>(ga, smem);
    xcd_barrier(xb);
    row_pass(nullptr, mbh, p.in[6] + layer * DM, h, nullptr, hn);
    xcd_barrier(xb);
    ga = GArgs{}; ga.A = hn; ga.lda = DM; ga.Bt = (bf16_t*)(ws + W_PG) + (size_t)layer * 2048 * 2048; ga.K = 2048; ga.M = TOK; ga.Npad = 2048;
    ga.A2 = (bf16_t*)(ws + A_PBF) + (size_t)layer * TOK * 256; ga.lda2 = 256; ga.Bt2 = (bf16_t*)(ws + W_PP) + (size_t)layer * 2048 * 256; ga.K2 = 256;
    ga.bias = p.in[26] + layer * DM; ga.hsrc = h; ga.C = (layer == 3) ? p.out : h; ga.ldc = DM;
    if (layer < 3) { ga.wnext = p.in[3] + (layer + 1) * DM; ga.hnext = mix; ga.rss = rss; }
    gemm_phase<EPI_PLE>(ga, smem);
    if (layer < 3) xcd_barrier(xb);
  }
}

extern "C" void kernel_launch(void* const* d_in, const int* in_sizes, int n_in, void* d_out, int out_size,
                              void* d_ws, size_t ws_size, hipStream_t stream) {
  static int grid_blocks = 0;
  if (!grid_blocks) {
    int dev = 0, cus = 0, per_cu = 0;
    (void)hipGetDevice(&dev);
    (void)hipDeviceGetAttribute(&cus, hipDeviceAttributeMultiprocessorCount, dev);
    (void)hipOccupancyMaxActiveBlocksPerMultiprocessor(&per_cu, mega, 256, 0);
    if (per_cu > 2) per_cu = 2;
    if (per_cu < 1) per_cu = 1;
    grid_blocks = cus * per_cu;
  }
  if (ws_size < WS_NEED) { fprintf(stderr, "workspace too small: %zu < %zu\n", ws_size, (size_t)WS_NEED); return; }
  Params p{};
  for (int i = 0; i < 28; ++i) p.in[i] = (const float*)d_in[i];
  p.out = (float*)d_out; p.ws = (char*)d_ws;
  void* args[] = {&p};
  (void)hipMemsetAsync((char*)d_ws + A_BAR, 0, 4096 * 4, stream);
  hipError_t e = hipLaunchCooperativeKernel((void*)mega, dim3(grid_blocks), dim3(256), args, 0, stream);
  if (e != hipSuccess) fprintf(stderr, "coop launch failed: %s (grid %d)\n", hipGetErrorString(e), grid_blocks);
}
```

```cpp
#include <hip/hip_runtime.h>
#include <hip/hip_cooperative_groups.h>
#include <cstdio>
#include <cstdint>
namespace cg = cooperative_groups;

typedef unsigned short bf16_t;
typedef short bf16x8 __attribute__((ext_vector_type(8)));
typedef short s16x4 __attribute__((ext_vector_type(4)));
typedef float f32x4 __attribute__((ext_vector_type(4)));
typedef unsigned u32x4 __attribute__((ext_vector_type(4)));
typedef unsigned u32x2 __attribute__((ext_vector_type(2)));
#define DI __device__ __forceinline__
#define LDSP(T, p) ((__attribute__((address_space(3))) T*)(p))

constexpr int TOK = 8192, SEQ = 2048, DM = 2048, NB = 4;
constexpr int ABN = 4176, ABP = 4224;
constexpr int NSN = 5168, NSP = 5248;
constexpr int FH = 5632;
constexpr int QS_MLA = 2, QS_CW = 2, QS_SEL = 2;
#define QB (64 * QS)
#define NQT (SEQ / QB)
constexpr int ZQ = 0, ZK = 512, ZV = 1024, ZG = 2048, ZA = 3072, ZCQ = 3088, ZCKV = 3600, ZKR = 4112;
constexpr int NQ = 0, NKC = 2048, NVC = 2560, NKS = 3072, NVS = 3584, NKW = 4096, NVW = 4608, NGL = 5120;

constexpr size_t al(size_t x) { return (x + 255) & ~(size_t)255; }
constexpr size_t W_ABIN = 0;
constexpr size_t W_UQ = W_ABIN + al((size_t)2 * ABP * 2048 * 2);
constexpr size_t W_UKV = W_UQ + al((size_t)2 * 1536 * 512 * 2);
constexpr size_t W_ABOUT = W_UKV + al((size_t)2 * 2048 * 512 * 2);
constexpr size_t W_NSIN = W_ABOUT + al((size_t)2 * 2048 * 2048 * 2);
constexpr size_t W_W1 = W_NSIN + al((size_t)2 * NSP * 2048 * 2);
constexpr size_t W_W2 = W_W1 + al((size_t)4 * 128 * 4096 * 2);
constexpr size_t W_NSOUT = W_W2 + al((size_t)4 * 128 * 128 * 2);
constexpr size_t W_FGU = W_NSOUT + al((size_t)2 * 2048 * 2048 * 2);
constexpr size_t W_FD = W_FGU + al((size_t)4 * 11264 * 2048 * 2);
constexpr size_t W_PG = W_FD + al((size_t)4 * 2048 * 5632 * 2);
constexpr size_t W_PP = W_PG + al((size_t)4 * 2048 * 2048 * 2);
constexpr size_t A_PBF = W_PP + al((size_t)4 * 2048 * 256 * 2);
constexpr size_t A_H = A_PBF + al((size_t)4 * TOK * 256 * 2);
constexpr size_t A_HN = A_H + al((size_t)TOK * 2048 * 4);
constexpr size_t A_MIX = A_HN + al((size_t)TOK * 2048 * 2);
constexpr size_t A_MB = A_MIX + al((size_t)TOK * 2048 * 2);
constexpr size_t A_R1 = A_MB + al((size_t)TOK * 2048 * 4);
constexpr size_t A_R3 = A_R1 + al((size_t)TOK * 5632 * 2);
constexpr size_t A_R4 = A_R3 + al((size_t)4 * 16 * 2048 * 128 * 4);
constexpr size_t A_R5 = A_R4 + al((size_t)2 * 2048 * 4096 * 2);
constexpr size_t A_KR = A_R5 + al((size_t)2 * TOK * 512 * 2);
constexpr size_t A_SEL = A_KR + al((size_t)TOK * 64 * 2);
constexpr size_t A_BAR = A_SEL + al((size_t)16 * 2048 * 4);
constexpr size_t A_RSS = A_BAR + al((size_t)4096 * 4);
constexpr size_t WS_NEED = A_RSS + al((size_t)TOK * 16 * 4);

struct Params {
  const float* in[28];
  float* out;
  char* ws;
};

DI float bf2f(bf16_t v) { return __uint_as_float(((unsigned)v) << 16); }
DI unsigned pack2(float lo, float hi) { unsigned r; asm("v_cvt_pk_bf16_f32 %0, %1, %2" : "=v"(r) : "v"(lo), "v"(hi)); return r; }
DI bf16_t f2bf(float f) { return (bf16_t)(pack2(f, 0.f) & 0xffffu); }
DI float lo2f(unsigned u) { return __uint_as_float(u << 16); }
DI float hi2f(unsigned u) { return __uint_as_float(u & 0xffff0000u); }
DI float wave_sum(float v) {
#pragma unroll
  for (int o = 32; o > 0; o >>= 1) v += __shfl_xor(v, o);
  return v;
}
DI int tidx() { int t = threadIdx.x; asm volatile("" : "+v"(t)); return t; }
DI f32x4 zero4() { float z0 = 0.f; asm volatile("" : "+v"(z0)); return (f32x4){z0, z0, z0, z0}; }
DI float sigmoidf_(float x) { return 1.f / (1.f + __expf(-x)); }
DI void rope_cs(int pos, int i, float l2step, float& c, float& s) {
  float inv = exp2f(-(float)i * l2step);
  float ang = (float)pos * inv;
  float rev = ang * 0.15915494309189535f;
  rev -= floorf(rev);
  c = __builtin_amdgcn_cosf(rev);
  s = __builtin_amdgcn_sinf(rev);
}

DI void transpose_job(const float* __restrict__ src, int K, int N, int Npad, bf16_t* __restrict__ dst, int mode, char* smem) {
  float* t = (float*)smem;
  const int tn = Npad / 64, tk = K / 64, tid = tidx();
  for (int tile = blockIdx.x; tile < tn * tk; tile += gridDim.x) {
    const int n0 = (tile % tn) * 64, k0 = (tile / tn) * 64;
#pragma unroll
    for (int i = 0; i < 4; ++i) {
      const int kr = (tid >> 4) + 16 * i, nc = (tid & 15) * 4, n = n0 + nc;
      float4 v = make_float4(0.f, 0.f, 0.f, 0.f);
      if (n < N) { const f32x4 t4 = __builtin_nontemporal_load((const f32x4*)(src + (size_t)(k0 + kr) * N + n)); v = make_float4(t4[0], t4[1], t4[2], t4[3]); }
      t[kr * 65 + nc + 0] = v.x; t[kr * 65 + nc + 1] = v.y; t[kr * 65 + nc + 2] = v.z; t[kr * 65 + nc + 3] = v.w;
    }
    __syncthreads();
    {
      const int nr = tid >> 2, kq = (tid & 3) * 16, n = n0 + nr;
      unsigned w[8];
#pragma unroll
      for (int e = 0; e < 8; ++e) w[e] = pack2(t[(kq + 2 * e) * 65 + nr], t[(kq + 2 * e + 1) * 65 + nr]);
      int row = n;
      if (mode == 1) row = (n >> 6) * 128 + (n & 63);
      else if (mode == 2) row = (n >> 6) * 128 + 64 + (n & 63);
      u32x4* d = (u32x4*)(dst + (size_t)row * K + k0 + kq);
      __builtin_nontemporal_store((u32x4){w[0], w[1], w[2], w[3]}, d);
      __builtin_nontemporal_store((u32x4){w[4], w[5], w[6], w[7]}, d + 1);
    }
    __syncthreads();
  }
}

DI void row_pass(const float* __restrict__ init, const bf16_t* __restrict__ add, const float* __restrict__ wpost,
                         float* __restrict__ h, const float* __restrict__ wnext, bf16_t* __restrict__ hn, float* __restrict__ zero_rss = nullptr) {
  const int tid = tidx(), lane = tid & 63, wv = tid >> 6;
  for (int row = blockIdx.x * 4 + wv; row < TOK; row += gridDim.x * 4) {
    const size_t ro = (size_t)row * DM;
    if (zero_rss && lane == 0) zero_rss[row] = 0.f;
    float4 hv[8];
    const float* hs = init ? init : h;
#pragma unroll
    for (int i = 0; i < 8; ++i) hv[i] = *(const float4*)(hs + ro + i * 256 + lane * 4);
    if (add) {
      float4 av[8]; float ss = 0.f;
#pragma unroll
      for (int i = 0; i < 8; ++i) { const u32x2 a2 = *(const u32x2*)(add + ro + i * 256 + lane * 4); av[i] = make_float4(lo2f(a2[0]), hi2f(a2[0]), lo2f(a2[1]), hi2f(a2[1])); ss += av[i].x * av[i].x + av[i].y * av[i].y + av[i].z * av[i].z + av[i].w * av[i].w; }
      ss = wave_sum(ss);
      const float r = rsqrtf(ss * (1.f / DM) + 1e-6f);
#pragma unroll
      for (int i = 0; i < 8; ++i) {
        const float4 w = *(const float4*)(wpost + i * 256 + lane * 4);
        hv[i].x += av[i].x * r * w.x; hv[i].y += av[i].y * r * w.y; hv[i].z += av[i].z * r * w.z; hv[i].w += av[i].w * r * w.w;
      }
    }
    if (add || init) {
#pragma unroll
      for (int i = 0; i < 8; ++i) *(float4*)(h + ro + i * 256 + lane * 4) = hv[i];
    }
    float r2 = 1.f;
    if (wnext) {
      float ss = 0.f;
#pragma unroll
      for (int i = 0; i < 8; ++i) ss += hv[i].x * hv[i].x + hv[i].y * hv[i].y + hv[i].z * hv[i].z + hv[i].w * hv[i].w;
      ss = wave_sum(ss);
      r2 = rsqrtf(ss * (1.f / DM) + 1e-6f);
    }
#pragma unroll
    for (int i = 0; i < 8; ++i) {
      float4 w = make_float4(1.f, 1.f, 1.f, 1.f);
      if (wnext) w = *(const float4*)(wnext + i * 256 + lane * 4);
      uint2 o; o.x = pack2(hv[i].x * r2 * w.x, hv[i].y * r2 * w.y); o.y = pack2(hv[i].z * r2 * w.z, hv[i].w * r2 * w.w);
      *(uint2*)(hn + ro + i * 256 + lane * 4) = o;
    }
  }
}

DI int toff(int row, int chunk) { return row * 128 + ((chunk ^ ((row >> 1) & 7)) << 4); }

DI void gemm_issue_first(const bf16_t* __restrict__ A, int lda, const bf16_t* __restrict__ Bt, int ldb, int m0, int n0, char* smem) {
  const int tid = tidx(), wave = tid >> 6, lane = tid & 63;
#pragma unroll
  for (int i = 0; i < 4; ++i) {
    const int row = (i * 4 + wave) * 8 + (lane >> 3), chunk = (lane & 7) ^ ((row >> 1) & 7);
    __builtin_amdgcn_global_load_lds((const unsigned*)(A + (size_t)(m0 + row) * lda + chunk * 8), LDSP(unsigned, smem + (i * 4 + wave) * 1024), 16, 0, 0);
    __builtin_amdgcn_global_load_lds((const unsigned*)(Bt + (size_t)(n0 + row) * ldb + chunk * 8), LDSP(unsigned, smem + 16384 + (i * 4 + wave) * 1024), 16, 0, 0);
  }
}
#define DSR(dst, addr, off) asm volatile("ds_read_b128 %0, %1 offset:%2" : "=v"(dst) : "v"(addr), "n"(off) : "memory")
template <bool DEEP = false>
DI void gemm_mainloop(const bf16_t* __restrict__ A, int lda, const bf16_t* __restrict__ Bt, int ldb, int K, int m0, int n0,
                      f32x4 (&acc)[2][8], char* smem, bool prefetched = false) {
  const int tid = tidx(), wave = tid >> 6, lane = tid & 63;
  const bf16_t* ag[4]; const bf16_t* bg[4];
#pragma unroll
  for (int i = 0; i < 4; ++i) {
    const int row = (i * 4 + wave) * 8 + (lane >> 3), chunk = (lane & 7) ^ ((row >> 1) & 7);
    ag[i] = A + (size_t)(m0 + row) * lda + chunk * 8;
    bg[i] = Bt + (size_t)(n0 + row) * ldb + chunk * 8;
  }
  const int nk = K >> 6;
#define GSTAGE(buf, kt)                                                                                                   \
  _Pragma("unroll") for (int i = 0; i < 4; ++i) {                                                                         \
    __builtin_amdgcn_global_load_lds((const unsigned*)(ag[i] + (kt) * 64), LDSP(unsigned, smem + (buf) * 32768 + (i * 4 + wave) * 1024), 16, 0, 0);          \
    __builtin_amdgcn_global_load_lds((const unsigned*)(bg[i] + (kt) * 64), LDSP(unsigned, smem + (buf) * 32768 + 16384 + (i * 4 + wave) * 1024), 16, 0, 0);  \
  }
  if (!prefetched) { GSTAGE(0, 0); }
  asm volatile("s_waitcnt vmcnt(0)" ::: "memory");
  __syncthreads();
#pragma unroll 1
  for (int kt = 0; kt < nk; ++kt) {
    const int cur = kt & 1;
    if (kt + 1 < nk) { GSTAGE(cur ^ 1, kt + 1); }
    const char* As = smem + cur * 32768; const char* Bs = As + 16384;
    if (DEEP) {
      const unsigned i16 = lane & 15, gq = lane >> 4, sw = (i16 >> 1) & 7;
      const unsigned base = (unsigned)(size_t)smem + cur * 32768 + i16 * 128;
      const unsigned a0 = base + wave * 4096 + ((gq ^ sw) << 4), a1 = base + wave * 4096 + (((4 + gq) ^ sw) << 4);
      const unsigned b0 = base + 16384 + ((gq ^ sw) << 4), b1 = base + 16384 + (((4 + gq) ^ sw) << 4);
      bf16x8 af[2][2], bfr[2][8];
      DSR(af[0][0], a0, 0); DSR(af[0][1], a0, 2048);
      DSR(bfr[0][0], b0, 0); DSR(bfr[0][1], b0, 2048); DSR(bfr[0][2], b0, 4096); DSR(bfr[0][3], b0, 6144);
      DSR(bfr[0][4], b0, 8192); DSR(bfr[0][5], b0, 10240); DSR(bfr[0][6], b0, 12288); DSR(bfr[0][7], b0, 14336);
      DSR(af[1][0], a1, 0); DSR(af[1][1], a1, 2048);
      DSR(bfr[1][0], b1, 0); DSR(bfr[1][1], b1, 2048); DSR(bfr[1][2], b1, 4096); DSR(bfr[1][3], b1, 6144);
      DSR(bfr[1][4], b1, 8192); DSR(bfr[1][5], b1, 10240); DSR(bfr[1][6], b1, 12288); DSR(bfr[1][7], b1, 14336);
      __builtin_amdgcn_sched_barrier(0);
      asm volatile("s_waitcnt lgkmcnt(10)" ::: "memory");
      __builtin_amdgcn_sched_barrier(0);
#pragma unroll
      for (int mi = 0; mi < 2; ++mi)
#pragma unroll
        for (int ni = 0; ni < 8; ++ni) acc[mi][ni] = __builtin_amdgcn_mfma_f32_16x16x32_bf16(bfr[0][ni], af[0][mi], acc[mi][ni], 0, 0, 0);
      __builtin_amdgcn_sched_barrier(0);
      asm volatile("s_waitcnt lgkmcnt(0)" ::: "memory");
      __builtin_amdgcn_sched_barrier(0);
#pragma unroll
      for (int mi = 0; mi < 2; ++mi)
#pragma unroll
        for (int ni = 0; ni < 8; ++ni) acc[mi][ni] = __builtin_amdgcn_mfma_f32_16x16x32_bf16(bfr[1][ni], af[1][mi], acc[mi][ni], 0, 0, 0);
      __builtin_amdgcn_sched_barrier(0);
    } else
#pragma unroll
    for (int ks = 0; ks < 2; ++ks) {
      const int chunk = ks * 4 + (lane >> 4);
      bf16x8 af[2], bfr[8];
#pragma unroll
      for (int mi = 0; mi < 2; ++mi) af[mi] = *(const bf16x8*)(As + toff(wave * 32 + mi * 16 + (lane & 15), chunk));
#pragma unroll
      for (int ni = 0; ni < 8; ++ni) bfr[ni] = *(const bf16x8*)(Bs + toff(ni * 16 + (lane & 15), chunk));
#pragma unroll
      for (int mi = 0; mi < 2; ++mi)
#pragma unroll
        for (int ni = 0; ni < 8; ++ni) acc[mi][ni] = __builtin_amdgcn_mfma_f32_16x16x32_bf16(bfr[ni], af[mi], acc[mi][ni], 0, 0, 0);
    }
    asm volatile("s_waitcnt vmcnt(0)" ::: "memory");
    __syncthreads();
  }
#undef GSTAGE
}
DI void gemm_mainloop_deep(const bf16_t* __restrict__ A, int lda, const bf16_t* __restrict__ Bt, int ldb, int K, int m0, int n0,
                           f32x4 (&acc)[2][8], char* smem, bool prefetched) {
  const int tid = tidx(), wave = tid >> 6, lane = tid & 63;
  const bf16_t* ag[4]; const bf16_t* bg[4];
#pragma unroll
  for (int i = 0; i < 4; ++i) {
    const int row = (i * 4 + wave) * 8 + (lane >> 3), chunk = (lane & 7) ^ ((row >> 1) & 7);
    ag[i] = A + (size_t)(m0 + row) * lda + chunk * 8;
    bg[i] = Bt + (size_t)(n0 + row) * ldb + chunk * 8;
  }
  const int nk = K >> 6;
#define GSTAGE(buf, kt)                                                                                                   \
  _Pragma("unroll") for (int i = 0; i < 4; ++i) {                                                                         \
    __builtin_amdgcn_global_load_lds((const unsigned*)(ag[i] + (kt) * 64), LDSP(unsigned, smem + (buf) * 32768 + (i * 4 + wave) * 1024), 16, 0, 0);          \
    __builtin_amdgcn_global_load_lds((const unsigned*)(bg[i] + (kt) * 64), LDSP(unsigned, smem + (buf) * 32768 + 16384 + (i * 4 + wave) * 1024), 16, 0, 0);  \
  }
#define RDSET(S, abase, bbase)                                                                                            \
  DSR(af[S][0], abase, 0); DSR(af[S][1], abase, 2048);                                                                    \
  DSR(bfr[S][0], bbase, 0); DSR(bfr[S][1], bbase, 2048); DSR(bfr[S][2], bbase, 4096); DSR(bfr[S][3], bbase, 6144);        \
  DSR(bfr[S][4], bbase, 8192); DSR(bfr[S][5], bbase, 10240); DSR(bfr[S][6], bbase, 12288); DSR(bfr[S][7], bbase, 14336);
#define MMSET(S)                                                                                                          \
  _Pragma("unroll") for (int mi = 0; mi < 2; ++mi)                                                                        \
  _Pragma("unroll") for (int ni = 0; ni < 8; ++ni) acc[mi][ni] = __builtin_amdgcn_mfma_f32_16x16x32_bf16(bfr[S][ni], af[S][mi], acc[mi][ni], 0, 0, 0);
  const unsigned i16 = lane & 15, gq = lane >> 4, sw = (i16 >> 1) & 7;
  const unsigned lb = (unsigned)(size_t)smem + i16 * 128;
  const unsigned o0 = (gq ^ sw) << 4, o1 = ((4 + gq) ^ sw) << 4;
  bf16x8 af[2][2], bfr[2][8];
  if (!prefetched) { GSTAGE(0, 0); }
  asm volatile("s_waitcnt vmcnt(0)" ::: "memory");
  __syncthreads();
  if (nk > 1) { GSTAGE(1, 1); }
  { const unsigned a = lb + wave * 4096 + o0, b = lb + 16384 + o0; RDSET(0, a, b); }
#pragma unroll 1
  for (int kt = 0; kt < nk; ++kt) {
    const unsigned cb = lb + (kt & 1) * 32768, nb = lb + ((kt & 1) ^ 1) * 32768;
    { const unsigned a = cb + wave * 4096 + o1, b = cb + 16384 + o1; RDSET(1, a, b); }
    __builtin_amdgcn_sched_barrier(0);
    asm volatile("s_waitcnt lgkmcnt(10)" ::: "memory");
    __builtin_amdgcn_sched_barrier(0);
    MMSET(0)
    __builtin_amdgcn_sched_barrier(0);
    asm volatile("s_waitcnt lgkmcnt(0)\n\ts_waitcnt vmcnt(0)" ::: "memory");
    __syncthreads();
    __builtin_amdgcn_sched_barrier(0);
    if (kt + 2 < nk) { GSTAGE(kt & 1, kt + 2); }
    if (kt + 1 < nk) { const unsigned a = nb + wave * 4096 + o0, b = nb + 16384 + o0; RDSET(0, a, b); }
    __builtin_amdgcn_sched_barrier(0);
    MMSET(1)
    __builtin_amdgcn_sched_barrier(0);
  }
#undef GSTAGE
#undef RDSET
#undef MMSET
}

enum { EPI_BF16 = 0, EPI_F32 = 1, EPI_SWIGLU = 2, EPI_GELU = 3, EPI_PLE = 4 };
struct GArgs {
  const bf16_t* A; int lda; const bf16_t* Bt; int K; int M; int Npad;
  void* C; int ldc;
  const bf16_t* A2; int lda2; const bf16_t* Bt2; int K2;
  const float* bias; const float* hsrc;
  const float* wnext; bf16_t* hnext; float* rss;
  const float* rowss;
};
DI float gelu_tanh(float x) {
  const float u = 0.7978845608028654f * (x + 0.044715f * x * x * x);
  const float t = 1.f - 2.f / (1.f + __expf(2.f * u));
  return 0.5f * x * (1.f + t);
}
template <int EPI>
DI void gemm_phase(const GArgs& g, char* smem) {
  const int ntm = g.M / 128, ntn = g.Npad / 128;
  const int tid = tidx(), lane = tid & 63, wave = tid >> 6;
  if ((int)blockIdx.x < ntm * ntn) gemm_issue_first(g.A, g.lda, g.Bt, g.K, (blockIdx.x % ntm) * 128, (blockIdx.x / ntm) * 128, smem);
  for (int tile = blockIdx.x; tile < ntm * ntn; tile += gridDim.x) {
    const int m0 = (tile % ntm) * 128, n0 = (tile / ntm) * 128;
    f32x4 acc[2][8];
#pragma unroll
    for (int mi = 0; mi < 2; ++mi)
#pragma unroll
      for (int ni = 0; ni < 8; ++ni) acc[mi][ni] = zero4();
    gemm_mainloop_deep(g.A, g.lda, g.Bt, g.K, g.K, m0, n0, acc, smem, true);
    if (EPI != EPI_PLE) {
      const int nt = tile + gridDim.x;
      if (nt < ntm * ntn) gemm_issue_first(g.A, g.lda, g.Bt, g.K, (nt % ntm) * 128, (nt / ntm) * 128, smem);
    }
    if (EPI == EPI_PLE) {
      f32x4 acc2[2][8];
#pragma unroll
      for (int mi = 0; mi < 2; ++mi)
#pragma unroll
        for (int ni = 0; ni < 8; ++ni) acc2[mi][ni] = zero4();
      gemm_mainloop(g.A2, g.lda2, g.Bt2, g.K2, g.K2, m0, n0, acc2, smem);
      {
        const int nt = tile + gridDim.x;
        if (nt < ntm * ntn) gemm_issue_first(g.A, g.lda, g.Bt, g.K, (nt % ntm) * 128, (nt / ntm) * 128, smem);
      }
#pragma unroll
      for (int mi = 0; mi < 2; ++mi) {
        const int row = m0 + wave * 32 + mi * 16 + (lane & 15);
        float ssq = 0.f;
#pragma unroll
        for (int ni = 0; ni < 8; ++ni) {
          const int col = n0 + ni * 16 + (lane >> 4) * 4;
          const float4 hb = *(const float4*)(g.hsrc + (size_t)row * DM + col);
          const float4 bb = *(const float4*)(g.bias + col);
          float4 o;
          o.x = hb.x + sigmoidf_(acc[mi][ni][0] + bb.x) * acc2[mi][ni][0];
          o.y = hb.y + sigmoidf_(acc[mi][ni][1] + bb.y) * acc2[mi][ni][1];
          o.z = hb.z + sigmoidf_(acc[mi][ni][2] + bb.z) * acc2[mi][ni][2];
          o.w = hb.w + sigmoidf_(acc[mi][ni][3] + bb.w) * acc2[mi][ni][3];
          *(float4*)((float*)g.C + (size_t)row * DM + col) = o;
          if (g.hnext) {
            const float4 wn = *(const float4*)(g.wnext + col);
            u32x2 hb2; hb2[0] = pack2(o.x * wn.x, o.y * wn.y); hb2[1] = pack2(o.z * wn.z, o.w * wn.w);
            *(u32x2*)(g.hnext + (size_t)row * DM + col) = hb2;
            ssq += o.x * o.x + o.y * o.y + o.z * o.z + o.w * o.w;
          }
        }
        if (g.hnext) {
          ssq += __shfl_xor(ssq, 16); ssq += __shfl_xor(ssq, 32);
          if (lane < 16) g.rss[(size_t)row * 16 + (n0 >> 7)] = ssq;
        }
      }
    } else {
#pragma unroll
      for (int mi = 0; mi < 2; ++mi) {
        const int row = m0 + wave * 32 + mi * 16 + (lane & 15);
        float rsc = 1.f;
        if (EPI == EPI_BF16) {
          if (g.rowss) {
            const f32x4* rp = (const f32x4*)(g.rowss + (size_t)row * 16);
            const f32x4 a0 = rp[0], a1 = rp[1], a2 = rp[2], a3 = rp[3];
            const float tot = ((a0[0] + a0[1]) + (a0[2] + a0[3])) + ((a1[0] + a1[1]) + (a1[2] + a1[3])) + ((a2[0] + a2[1]) + (a2[2] + a2[3])) + ((a3[0] + a3[1]) + (a3[2] + a3[3]));
            rsc = rsqrtf(tot * (1.f / DM) + 1e-6f);
          }
        }
        if (EPI == EPI_SWIGLU) {
#pragma unroll
          for (int ni = 0; ni < 4; ++ni) {
            const int col = (n0 >> 1) + ni * 16 + (lane >> 4) * 4;
            float v[4];
#pragma unroll
            for (int r = 0; r < 4; ++r) { const float gt = acc[mi][ni][r]; v[r] = gt * sigmoidf_(gt) * acc[mi][ni + 4][r]; }
            uint2 o; o.x = pack2(v[0], v[1]); o.y = pack2(v[2], v[3]);
            *(uint2*)((bf16_t*)g.C + (size_t)row * g.ldc + col) = o;
          }
        } else {
#pragma unroll
          for (int ni = 0; ni < 8; ++ni) {
            const int col = n0 + ni * 16 + (lane >> 4) * 4;
            if (EPI == EPI_F32) {
              *(f32x4*)((float*)g.C + (size_t)row * g.ldc + col) = acc[mi][ni];
            } else {
              float v[4];
#pragma unroll
              for (int r = 0; r < 4; ++r) v[r] = (EPI == EPI_GELU) ? gelu_tanh(acc[mi][ni][r]) : acc[mi][ni][r] * rsc;
              uint2 o; o.x = pack2(v[0], v[1]); o.y = pack2(v[2], v[3]);
              *(uint2*)((bf16_t*)g.C + (size_t)row * g.ldc + col) = o;
            }
          }
        }
      }
    }
  }
}

DI void gemm_tail_splitk(const bf16_t* __restrict__ A, const bf16_t* __restrict__ Bt_tail, float* __restrict__ slab, char* smem) {
  const int tid = tidx(), lane = tid & 63, wave = tid >> 6;
  for (int u = blockIdx.x; u < 512; u += gridDim.x) {
    const int mt = u & 63, ks = u >> 6;
    f32x4 acc[2][8];
#pragma unroll
    for (int mi = 0; mi < 2; ++mi)
#pragma unroll
      for (int ni = 0; ni < 8; ++ni) acc[mi][ni] = zero4();
    gemm_mainloop(A + ks * 256, DM, Bt_tail + ks * 256, DM, 256, mt * 128, 0, acc, smem);
#pragma unroll
    for (int mi = 0; mi < 2; ++mi) {
      const int row = mt * 128 + wave * 32 + mi * 16 + (lane & 15);
#pragma unroll
      for (int ni = 0; ni < 8; ++ni) *(f32x4*)(slab + ((size_t)ks * TOK + row) * 128 + ni * 16 + (lane >> 4) * 4) = acc[mi][ni];
    }
  }
}
DI float row_rsc(const float* __restrict__ rowss, int row) {
  if (!rowss) return 1.f;
  const f32x4* rp = (const f32x4*)(rowss + (size_t)row * 16);
  const f32x4 a0 = rp[0], a1 = rp[1], a2 = rp[2], a3 = rp[3];
  const float tot = ((a0[0] + a0[1]) + (a0[2] + a0[3])) + ((a1[0] + a1[1]) + (a1[2] + a1[3])) + ((a2[0] + a2[1]) + (a2[2] + a2[3])) + ((a3[0] + a3[1]) + (a3[2] + a3[3]));
  return rsqrtf(tot * (1.f / DM) + 1e-6f);
}
DI float slab_sum(const float* __restrict__ slab, int tok, int col) {
  float v = 0.f;
#pragma unroll
  for (int ks = 0; ks < 8; ++ks) v += slab[((size_t)ks * TOK + tok) * 128 + col];
  return v;
}

template <bool WANT_Q>
DI void gla_prologue(int tid, const bf16_t* __restrict__ z, size_t tok0, int h, const float (&wu)[16], float ba,
                     float* qdT, float* kiT, float* alr, float* seg, float* Ed) {
  const int d_ = tid & 63, sg = tid >> 6;
  {
    const int t = tid >> 2, q4 = (tid & 3) * 4;
    const u32x2 av = *(const u32x2*)(z + (tok0 + t) * ABP + ZA + q4);
    *(f32x4*)(alr + t * 16 + q4) = (f32x4){lo2f(av[0]), hi2f(av[0]), lo2f(av[1]), hi2f(av[1])};
  }
  __syncthreads();
  float bb[16];
  {
    float run = 0.f;
#pragma unroll
    for (int i = 0; i < 16; ++i) {
      const int t = sg * 16 + i;
      float x = ba;
#pragma unroll
      for (int r = 0; r < 16; ++r) x += alr[t * 16 + r] * wu[r];
      const float ls = fminf(x, 0.f) - log1pf(__expf(-fabsf(x)));
      run += ls * (1.f / 16.f);
      bb[i] = run;
    }
    seg[sg * 64 + d_] = run;
  }
  __syncthreads();
  {
    float pre = 0.f, tot = 0.f;
#pragma unroll
    for (int s2 = 0; s2 < 4; ++s2) { const float v = seg[s2 * 64 + d_]; tot += v; if (s2 < sg) pre += v; }
    if (sg == 0) Ed[d_] = __expf(tot);
#pragma unroll
    for (int i = 0; i < 16; ++i) {
      const int t = sg * 16 + i;
      const float bt = bb[i] + pre;
      if (WANT_Q) qdT[d_ * 68 + t] = bf2f(z[(tok0 + t) * ABP + ZQ + h * 64 + d_]) * 0.125f * __expf(bt);
      kiT[d_ * 68 + t] = bf2f(z[(tok0 + t) * ABP + ZK + h * 64 + d_]) * __expf(-bt);
    }
  }
  __syncthreads();
}

DI void gla_pass2(float* __restrict__ Ubuf, const float* __restrict__ Ebuf) {
  const int idx = blockIdx.x * 256 + tidx();
  if (idx < 32 * 64 * 32) {
    const int bh = idx >> 11, d = (idx >> 5) & 63, v4 = idx & 31;
    f32x4 S = (f32x4){0.f, 0.f, 0.f, 0.f};
#pragma unroll 8
    for (int n = 0; n < 32; ++n) {
      float* p = Ubuf + (((size_t)bh * 32 + n) * 64 + d) * 128 + v4 * 4;
      const f32x4 u = *(const f32x4*)p;
      const float e = Ebuf[((size_t)bh * 32 + n) * 64 + d];
      *(f32x4*)p = S;
      S = e * (S + u);
    }
  }
}

DI void mla_prep(int first, int stride, const bf16_t* __restrict__ z, const float* __restrict__ qnw, const float* __restrict__ kvnw,
                         const int* __restrict__ pos, bf16_t* __restrict__ cqn, bf16_t* __restrict__ ckvn, bf16_t* __restrict__ krope,
                         const float* __restrict__ slab, const float* __restrict__ rowss) {
  const int tid = tidx(), lane = tid & 63, wv = tid >> 6;
  for (int tok = first * 4 + wv; tok < TOK; tok += stride * 4) {
    const bf16_t* zr = z + (size_t)tok * ABP;
    const float rsc = row_rsc(rowss, tok);
#pragma unroll
    for (int part = 0; part < 2; ++part) {
      const uint4 v = *(const uint4*)(zr + (part ? ZCKV : ZCQ) + lane * 8);
      float x[8] = {lo2f(v.x), hi2f(v.x), lo2f(v.y), hi2f(v.y), lo2f(v.z), hi2f(v.z), lo2f(v.w), hi2f(v.w)};
      if (part == 1 && lane >= 62) {
#pragma unroll
        for (int e = 0; e < 8; ++e) x[e] = slab_sum(slab, tok, (lane - 62) * 8 + e) * rsc;
      }
      float ss = 0.f;
#pragma unroll
      for (int e = 0; e < 8; ++e) ss += x[e] * x[e];
      ss = wave_sum(ss);
      const float r = rsqrtf(ss * (1.f / 512.f) + 1e-6f);
      const float* w = (part ? kvnw : qnw) + lane * 8;
      uint4 o;
      o.x = pack2(x[0] * r * w[0], x[1] * r * w[1]); o.y = pack2(x[2] * r * w[2], x[3] * r * w[3]);
      o.z = pack2(x[4] * r * w[4], x[5] * r * w[5]); o.w = pack2(x[6] * r * w[6], x[7] * r * w[7]);
      *(uint4*)((part ? ckvn : cqn) + (size_t)tok * 512 + lane * 8) = o;
    }
    if (lane < 32) {
      float c, s; rope_cs(pos[tok], lane, 13.287712379549449f / 32.f, c, s);
      const float x1 = slab_sum(slab, tok, 16 + lane) * rsc, x2 = slab_sum(slab, tok, 48 + lane) * rsc;
      krope[(size_t)tok * 64 + lane] = f2bf(x1 * c - x2 * s);
      krope[(size_t)tok * 64 + 32 + lane] = f2bf(x2 * c + x1 * s);
    }
  }
}

DI void gla_post(const float* __restrict__ ogla, const bf16_t* __restrict__ z, const float* __restrict__ gw, bf16_t* __restrict__ mix) {
  const int tid = tidx(), lane = tid & 63, wv = tid >> 6;
  for (int tok = blockIdx.x * 4 + wv; tok < TOK; tok += gridDim.x * 4) {
    float x[16];
#pragma unroll
    for (int i = 0; i < 4; ++i) { const float4 v = *(const float4*)(ogla + (size_t)tok * 1024 + lane * 16 + i * 4); x[4 * i] = v.x; x[4 * i + 1] = v.y; x[4 * i + 2] = v.z; x[4 * i + 3] = v.w; }
    float ss = 0.f;
#pragma unroll
    for (int e = 0; e < 16; ++e) ss += x[e] * x[e];
    ss += __shfl_xor(ss, 1); ss += __shfl_xor(ss, 2); ss += __shfl_xor(ss, 4);
    const float r = rsqrtf(ss * (1.f / 128.f) + 1e-6f);
    const uint4 g0 = *(const uint4*)(z + (size_t)tok * ABP + ZG + lane * 16);
    const uint4 g1 = *(const uint4*)(z + (size_t)tok * ABP + ZG + lane * 16 + 8);
    const float gg[16] = {lo2f(g0.x), hi2f(g0.x), lo2f(g0.y), hi2f(g0.y), lo2f(g0.z), hi2f(g0.z), lo2f(g0.w), hi2f(g0.w),
                          lo2f(g1.x), hi2f(g1.x), lo2f(g1.y), hi2f(g1.y), lo2f(g1.z), hi2f(g1.z), lo2f(g1.w), hi2f(g1.w)};
    const float* w = gw + (lane & 7) * 16;
    float y[16];
#pragma unroll
    for (int e = 0; e < 16; ++e) y[e] = x[e] * r * w[e] * (gg[e] * sigmoidf_(gg[e]));
    uint4 o0, o1;
    o0.x = pack2(y[0], y[1]); o0.y = pack2(y[2], y[3]); o0.z = pack2(y[4], y[5]); o0.w = pack2(y[6], y[7]);
    o1.x = pack2(y[8], y[9]); o1.y = pack2(y[10], y[11]); o1.z = pack2(y[12], y[13]); o1.w = pack2(y[14], y[15]);
    *(uint4*)(mix + (size_t)tok * DM + lane * 16) = o0;
    *(uint4*)(mix + (size_t)tok * DM + lane * 16 + 8) = o1;
  }
}

DI int koff(int row, int chunk) { return row * 256 + ((chunk ^ (row & 15)) << 4); }
DI int k2off(int row, int chunk) { return row * 128 + ((chunk ^ ((row >> 1) & 7)) << 4); }
DI int voff(int row, int chunk) { return row * 256 + ((((chunk >> 1) ^ (row & 7)) << 5) | ((chunk & 1) << 4)); }

DI void ldg_tile(int tid, const bf16_t* __restrict__ g, int ld, u32x4 (&r)[4]) {
#pragma unroll
  for (int i = 0; i < 4; ++i) { const int idx = tid + 256 * i, row = idx >> 4, ch = idx & 15; r[i] = *(const u32x4*)(g + (size_t)row * ld + ch * 8); }
}
DI void sts_tile_k(int tid, const u32x4 (&r)[4], char* dst) {
#pragma unroll
  for (int i = 0; i < 4; ++i) { const int idx = tid + 256 * i, row = idx >> 4, ch = idx & 15; *(u32x4*)(dst + koff(row, ch)) = r[i]; }
}
DI void sts_tile_v(int tid, const u32x4 (&r)[4], char* dst) {
#pragma unroll
  for (int i = 0; i < 4; ++i) { const int idx = tid + 256 * i, row = idx >> 4, ch = idx & 15; *(u32x4*)(dst + voff(row, ch)) = r[i]; }
}
DI void ldg_tile_k2(int tid, const bf16_t* __restrict__ g, int ld, u32x4 (&r)[2]) {
#pragma unroll
  for (int i = 0; i < 2; ++i) { const int idx = tid + 256 * i, row = idx >> 3, ch = idx & 7; r[i] = *(const u32x4*)(g + (size_t)row * ld + ch * 8); }
}
DI void sts_tile_k2(int tid, const u32x4 (&r)[2], char* dst) {
#pragma unroll
  for (int i = 0; i < 2; ++i) { const int idx = tid + 256 * i, row = idx >> 3, ch = idx & 7; *(u32x4*)(dst + k2off(row, ch)) = r[i]; }
}
DI void load_tile_k(int tid, const bf16_t* __restrict__ g, int ld, char* dst) { u32x4 r[4]; ldg_tile(tid, g, ld, r); sts_tile_k(tid, r, dst); }
DI void load_tile_v(int tid, const bf16_t* __restrict__ g, int ld, char* dst) { u32x4 r[4]; ldg_tile(tid, g, ld, r); sts_tile_v(tid, r, dst); }
template <int NKS, int QS>
DI void qk_tile(const char* Ks, const bf16x8 (&qf)[QS][6], int ks0, f32x4 (&s)[4][QS], int lane) {
#pragma unroll
  for (int ks = 0; ks < NKS; ++ks)
#pragma unroll
    for (int kt = 0; kt < 4; ++kt) {
      const bf16x8 kf = *(const bf16x8*)(Ks + koff(kt * 16 + (lane & 15), ks * 4 + (lane >> 4)));
#pragma unroll
      for (int qs = 0; qs < QS; ++qs) s[kt][qs] = __builtin_amdgcn_mfma_f32_16x16x32_bf16(kf, qf[qs][ks0 + ks], s[kt][qs], 0, 0, 0);
    }
}
template <int QS>
DI void qk_tile2(const char* K2s, const bf16x8 (&qf)[QS][6], f32x4 (&s)[4][QS], int lane) {
#pragma unroll
  for (int ks = 0; ks < 2; ++ks)
#pragma unroll
    for (int kt = 0; kt < 4; ++kt) {
      const bf16x8 kf = *(const bf16x8*)(K2s + k2off(kt * 16 + (lane & 15), ks * 4 + (lane >> 4)));
#pragma unroll
      for (int qs = 0; qs < QS; ++qs) s[kt][qs] = __builtin_amdgcn_mfma_f32_16x16x32_bf16(kf, qf[qs][4 + ks], s[kt][qs], 0, 0, 0);
    }
}
template <int QS>
DI void pv_tile(const char* Vs, const f32x4 (&s)[4][QS], f32x4 (&o)[QS][8], int lane) {
  const int g = lane >> 4, i = lane & 15;
#pragma unroll
  for (int c = 0; c < 2; ++c) {
    bf16x8 pf[QS];
#pragma unroll
    for (int qs = 0; qs < QS; ++qs) {
      union { uint4 u; bf16x8 v; } cv;
      cv.u.x = pack2(s[2 * c][qs][0], s[2 * c][qs][1]); cv.u.y = pack2(s[2 * c][qs][2], s[2 * c][qs][3]);
      cv.u.z = pack2(s[2 * c + 1][qs][0], s[2 * c + 1][qs][1]); cv.u.w = pack2(s[2 * c + 1][qs][2], s[2 * c + 1][qs][3]);
      pf[qs] = cv.v;
    }
    const int r1 = 32 * c + 4 * g + (i >> 2), r2 = r1 + 16;
#pragma unroll
    for (int dt = 0; dt < 8; ++dt) {
      const s16x4 lo = __builtin_amdgcn_ds_read_tr16_b64_v4i16(LDSP(s16x4, Vs + r1 * 256 + ((dt ^ (r1 & 7)) << 5) + 8 * (i & 3)));
      const s16x4 hi = __builtin_amdgcn_ds_read_tr16_b64_v4i16(LDSP(s16x4, Vs + r2 * 256 + ((dt ^ (r2 & 7)) << 5) + 8 * (i & 3)));
      bf16x8 vf; vf[0] = lo[0]; vf[1] = lo[1]; vf[2] = lo[2]; vf[3] = lo[3]; vf[4] = hi[0]; vf[5] = hi[1]; vf[6] = hi[2]; vf[7] = hi[3];
#pragma unroll
      for (int qs = 0; qs < QS; ++qs) o[qs][dt] = __builtin_amdgcn_mfma_f32_16x16x32_bf16(vf, pf[qs], o[qs][dt], 0, 0, 0);
    }
  }
}

enum { AM_MLA = 0, AM_WIN = 1, AM_SEL = 2 };
template <int MODE, int QS>
DI void softmax_tile(f32x4 (&s)[4][QS], f32x4 (&o)[QS][8], float (&m)[QS], float (&l)[QS], const int (&qi)[QS], const unsigned (&qmask)[QS],
                     int kbase, int tilebit, float sc, int lane, bool interior) {
  const int g = lane >> 4;
#pragma unroll
  for (int qs = 0; qs < QS; ++qs) {
    float mx = -1e30f;
    if (interior) {
      float sce = sc, bias = 0.f;
      if (MODE == AM_SEL) { const bool on = (qmask[qs] >> tilebit) & 1u; sce = on ? sc : 0.f; bias = on ? 0.f : -1e30f; }
#pragma unroll
      for (int kt = 0; kt < 4; ++kt)
#pragma unroll
        for (int r = 0; r < 4; ++r) { const float x = fmaf(s[kt][qs][r], sce, bias); s[kt][qs][r] = x; mx = fmaxf(mx, x); }
    } else {
#pragma unroll
      for (int kt = 0; kt < 4; ++kt)
#pragma unroll
        for (int r = 0; r < 4; ++r) {
          const int kj = kbase + kt * 16 + 4 * g + r;
          bool v = kj <= qi[qs];
          if (MODE == AM_WIN) v = v && (kj > qi[qs] - 512);
          if (MODE == AM_SEL) v = v && ((qmask[qs] >> tilebit) & 1u);
          const float x = v ? s[kt][qs][r] * sc : -1e30f;
          s[kt][qs][r] = x;
          mx = fmaxf(mx, x);
        }
    }
    mx = fmaxf(mx, __shfl_xor(mx, 16)); mx = fmaxf(mx, __shfl_xor(mx, 32));
    const bool keep = __all(mx - m[qs] <= 11.5416f);
    const float mn = keep ? m[qs] : fmaxf(m[qs], mx);
    const float alpha = keep ? 1.f : __builtin_amdgcn_exp2f(m[qs] - mn);
    m[qs] = mn;
    const float mnc = fmaxf(mn, -1e20f);
    float ps = 0.f;
#pragma unroll
    for (int kt = 0; kt < 4; ++kt)
#pragma unroll
      for (int r = 0; r < 4; ++r) { const float p = __builtin_amdgcn_exp2f(s[kt][qs][r] - mnc); s[kt][qs][r] = p; ps += p; }
    l[qs] = l[qs] * alpha + ps;
    if (!keep) {
#pragma unroll
      for (int dt = 0; dt < 8; ++dt) o[qs][dt] *= alpha;
    }
  }
}

template <int QS>
DI void mla_attn_item(int item, const bf16_t* __restrict__ q, const bf16_t* __restrict__ kv, const bf16_t* __restrict__ krope,
                              const int* __restrict__ pos, bf16_t* __restrict__ mix, char* smem) {
  const int tid = tidx(), lane = tid & 63, wave = tid >> 6, g = lane >> 4, i16 = lane & 15;
  const int qt = (NQT - 1) - (item >> 5), bh = item & 31, b = bh >> 3, h = bh & 7;
  const int q0 = qt * QB;
  const size_t tb = (size_t)b * SEQ;
  char* Ks = smem; char* Vs = smem + 16384; char* K2s = smem + 32768;
  bf16x8 qf[QS][6]; int qi[QS]; unsigned qm[QS] = {};
#pragma unroll
  for (int qs = 0; qs < QS; ++qs) {
    qi[qs] = q0 + wave * (16 * QS) + qs * 16 + i16;
    const bf16_t* qp = q + (tb + qi[qs]) * 1536 + h * 192;
#pragma unroll
    for (int ks = 0; ks < 6; ++ks) qf[qs][ks] = *(const bf16x8*)(qp + ks * 32 + g * 8);
    const int p = pos[tb + qi[qs]];
#pragma unroll
    for (int j = 0; j < 8; ++j) {
      float c, s; rope_cs(p, 8 * g + j, 13.287712379549449f / 32.f, c, s);
      const float x1 = bf2f((bf16_t)qf[qs][4][j]), x2 = bf2f((bf16_t)qf[qs][5][j]);
      qf[qs][4][j] = (short)f2bf(x1 * c - x2 * s);
      qf[qs][5][j] = (short)f2bf(x2 * c + x1 * s);
    }
  }
  f32x4 o[QS][8];
#pragma unroll
  for (int qs = 0; qs < QS; ++qs)
#pragma unroll
    for (int dt = 0; dt < 8; ++dt) o[qs][dt] = (f32x4){0.f, 0.f, 0.f, 0.f};
  float m[QS], l[QS];
#pragma unroll
  for (int qs = 0; qs < QS; ++qs) { m[qs] = -1e30f; l[qs] = 0.f; }
  const float sc = 0.07216878364870322f * 1.4426950408889634f;
  const int ntile = (qt + 1) * QS;
#pragma unroll 1
  for (int j = 0; j < ntile; ++j) {
    __syncthreads();
    load_tile_k(tid, kv + (tb + j * 64) * 2048 + h * 256, 2048, Ks);
    load_tile_v(tid, kv + (tb + j * 64) * 2048 + h * 256 + 128, 2048, Vs);
    { u32x4 r2[2]; ldg_tile_k2(tid, krope + (tb + j * 64) * 64, 64, r2); sts_tile_k2(tid, r2, K2s); }
    __syncthreads();
    f32x4 s[4][QS];
#pragma unroll
    for (int kt = 0; kt < 4; ++kt)
#pragma unroll
      for (int qs = 0; qs < QS; ++qs) s[kt][qs] = (f32x4){0.f, 0.f, 0.f, 0.f};
    qk_tile<4, QS>(Ks, qf, 0, s, lane);
    qk_tile2<QS>(K2s, qf, s, lane);
    softmax_tile<AM_MLA, QS>(s, o, m, l, qi, qm, j * 64, 0, sc, lane, j * 64 + 63 <= q0);
    pv_tile<QS>(Vs, s, o, lane);
  }
#pragma unroll
  for (int qs = 0; qs < QS; ++qs) {
    float lt = l[qs]; lt += __shfl_xor(lt, 16); lt += __shfl_xor(lt, 32);
    const float inv = lt > 0.f ? 1.f / lt : 0.f;
    bf16_t* op = mix + (tb + qi[qs]) * DM + 1024 + h * 128;
#pragma unroll
    for (int dt = 0; dt < 8; ++dt) {
      uint2 w; w.x = pack2(o[qs][dt][0] * inv, o[qs][dt][1] * inv); w.y = pack2(o[qs][dt][2] * inv, o[qs][dt][3] * inv);
      *(uint2*)(op + dt * 16 + 4 * g) = w;
    }
  }
}

DI void gla_pass1(int item, const bf16_t* __restrict__ z, const float* __restrict__ w_up, const float* __restrict__ b_alpha,
                  float* __restrict__ Ubuf, float* __restrict__ Ebuf, char* smem) {
  const int tid = tidx(), lane = tid & 63, wave = tid >> 6, g = lane >> 4;
  const int b = item >> 8, h = (item >> 5) & 7, n = item & 31;
  float* kiT = (float*)smem;
  char* Vs = (char*)(kiT + 64 * 68);
  float* alr = (float*)(Vs + 16384);
  float* seg = alr + 64 * 16;
  float* Ed = seg + 256;
  float wu[16];
#pragma unroll
  for (int r = 0; r < 16; ++r) wu[r] = w_up[r * 512 + h * 64 + (tid & 63)];
  const float ba = b_alpha[h * 64 + (tid & 63)];
  const size_t tok0 = (size_t)b * SEQ + n * 64;
  __syncthreads();
  load_tile_v(tid, z + tok0 * ABP + ZV + h * 128, ABP, Vs);
  gla_prologue<false>(tid, z, tok0, h, wu, ba, nullptr, kiT, alr, seg, Ed);
  const int dq = wave * 16 + (lane & 15);
  f32x4 sk[4][1], o[1][8];
#pragma unroll
  for (int kt = 0; kt < 4; ++kt) sk[kt][0] = *(const f32x4*)(kiT + dq * 68 + kt * 16 + 4 * g);
#pragma unroll
  for (int dt = 0; dt < 8; ++dt) o[0][dt] = zero4();
  pv_tile<1>(Vs, sk, o, lane);
  float* up = Ubuf + ((size_t)item * 64 + dq) * 128 + 4 * g;
#pragma unroll
  for (int dt = 0; dt < 8; ++dt) *(f32x4*)(up + dt * 16) = o[0][dt];
  if (g == 0) Ebuf[(size_t)item * 64 + dq] = Ed[dq];
}

DI void gla_pass3(int item, const bf16_t* __restrict__ z, const float* __restrict__ w_up, const float* __restrict__ b_alpha,
                  const float* __restrict__ Sbuf, const float* __restrict__ gw, bf16_t* __restrict__ mix, char* smem) {
  const int tid = tidx(), lane = tid & 63, wave = tid >> 6, g = lane >> 4;
  const int b = item >> 8, h = (item >> 5) & 7, n = item & 31;
  float* qdT = (float*)smem;
  float* kiT = qdT + 64 * 68;
  char* Ss = (char*)(kiT + 64 * 68);
  float* alr = (float*)(Ss + 16384);
  float* seg = alr + 64 * 16;
  float* Ed = seg + 256;
  char* Vs = smem;
  float wu[16];
#pragma unroll
  for (int r = 0; r < 16; ++r) wu[r] = w_up[r * 512 + h * 64 + (tid & 63)];
  const float ba = b_alpha[h * 64 + (tid & 63)];
  const size_t tok0 = (size_t)b * SEQ + n * 64;
  __syncthreads();
  gla_prologue<true>(tid, z, tok0, h, wu, ba, qdT, kiT, alr, seg, Ed);
  const int iq = wave * 16 + (lane & 15);
  f32x4 sq[4][1];
  {
    const int ti = tid >> 4, tj = tid & 15;
    float a4[4][4];
#pragma unroll
    for (int i = 0; i < 4; ++i)
#pragma unroll
      for (int j = 0; j < 4; ++j) a4[i][j] = 0.f;
    if (tj <= ti) {
#pragma unroll 4
      for (int d = 0; d < 64; ++d) {
        const f32x4 qv = *(const f32x4*)(qdT + d * 68 + ti * 4);
        const f32x4 kv = *(const f32x4*)(kiT + d * 68 + tj * 4);
#pragma unroll
        for (int i = 0; i < 4; ++i)
#pragma unroll
          for (int j = 0; j < 4; ++j) a4[i][j] += qv[i] * kv[j];
      }
    }
#pragma unroll
    for (int kt = 0; kt < 4; ++kt)
#pragma unroll
      for (int r = 0; r < 4; ++r) sq[kt][0][r] = qdT[(kt * 16 + 4 * g + r) * 68 + iq];
    __syncthreads();
#pragma unroll
    for (int i = 0; i < 4; ++i) {
      f32x4 o;
#pragma unroll
      for (int j = 0; j < 4; ++j) o[j] = (tj * 4 + j <= ti * 4 + i) ? a4[i][j] : 0.f;
      *(f32x4*)(kiT + (ti * 4 + i) * 68 + tj * 4) = o;
    }
  }
  load_tile_v(tid, z + tok0 * ABP + ZV + h * 128, ABP, Vs);
  {
    const float* Sg = Sbuf + (size_t)item * 64 * 128;
#pragma unroll
    for (int i = 0; i < 4; ++i) {
      const int idx = tid + 256 * i, row = idx >> 4, ch = idx & 15;
      const f32x4 x0 = *(const f32x4*)(Sg + row * 128 + ch * 8), x1 = *(const f32x4*)(Sg + row * 128 + ch * 8 + 4);
      u32x4 w; w[0] = pack2(x0[0], x0[1]); w[1] = pack2(x0[2], x0[3]); w[2] = pack2(x1[0], x1[1]); w[3] = pack2(x1[2], x1[3]);
      *(u32x4*)(Ss + voff(row, ch)) = w;
    }
  }
  __syncthreads();
  f32x4 o[1][8];
#pragma unroll
  for (int dt = 0; dt < 8; ++dt) o[0][dt] = (f32x4){0.f, 0.f, 0.f, 0.f};
  {
    f32x4 sa[4][1];
#pragma unroll
    for (int kt = 0; kt < 4; ++kt) sa[kt][0] = *(const f32x4*)(kiT + iq * 68 + kt * 16 + 4 * g);
    pv_tile<1>(Vs, sa, o, lane);
    pv_tile<1>(Ss, sq, o, lane);
  }
  {
    float ssq = 0.f;
#pragma unroll
    for (int dt = 0; dt < 8; ++dt) ssq += (o[0][dt][0] * o[0][dt][0] + o[0][dt][1] * o[0][dt][1]) + (o[0][dt][2] * o[0][dt][2] + o[0][dt][3] * o[0][dt][3]);
    ssq += __shfl_xor(ssq, 16); ssq += __shfl_xor(ssq, 32);
    const float r = rsqrtf(ssq * (1.f / 128.f) + 1e-6f);
#pragma unroll
    for (int dt = 0; dt < 8; ++dt) {
      const int dv = dt * 16 + 4 * g, col = h * 128 + dv;
      const u32x2 gq = *(const u32x2*)(z + (tok0 + iq) * ABP + ZG + col);
      const float gg[4] = {lo2f(gq[0]), hi2f(gq[0]), lo2f(gq[1]), hi2f(gq[1])};
      const f32x4 w = *(const f32x4*)(gw + dv);
      float y[4];
#pragma unroll
      for (int e = 0; e < 4; ++e) y[e] = o[0][dt][e] * r * w[e] * (gg[e] * sigmoidf_(gg[e]));
      u32x2 ov; ov[0] = pack2(y[0], y[1]); ov[1] = pack2(y[2], y[3]);
      *(u32x2*)(mix + (tok0 + iq) * DM + col) = ov;
    }
  }
}

DI void rope4(bf16_t* p1, const float (&c)[4], const float (&sn)[4], float (&y1)[4], float (&y2)[4]) {
  const u32x2 a = *(const u32x2*)p1, b = *(const u32x2*)(p1 + 64);
  const float x1[4] = {lo2f(a[0]), hi2f(a[0]), lo2f(a[1]), hi2f(a[1])}, x2[4] = {lo2f(b[0]), hi2f(b[0]), lo2f(b[1]), hi2f(b[1])};
#pragma unroll
  for (int e = 0; e < 4; ++e) { y1[e] = x1[e] * c[e] - x2[e] * sn[e]; y2[e] = x2[e] * c[e] + x1[e] * sn[e]; }
}
DI void st4bf(bf16_t* p, const float (&y)[4]) { u32x2 o; o[0] = pack2(y[0], y[1]); o[1] = pack2(y[2], y[3]); *(u32x2*)p = o; }
DI void nsa_prep(bf16_t* __restrict__ z, const int* __restrict__ pos, const float* __restrict__ cpos,
                 bf16_t* __restrict__ aflk, bf16_t* __restrict__ aflv, const float* __restrict__ slab, const float* __restrict__ rowss) {
  const int tid = tidx(), lane = tid & 63, wv = tid >> 6;
  for (int idx = blockIdx.x * 256 + tid; idx < 2 * 16 * 512; idx += gridDim.x * 256) {
    const int which = idx >> 13, r = idx & 8191, bg = r >> 9, ch = r & 511;
    *(u32x4*)((which ? aflv : aflk) + ((size_t)bg * 128 + 127) * 4096 + ch * 8) = (u32x4){0u, 0u, 0u, 0u};
  }
  const int hq = lane >> 4, d0 = (lane & 15) * 4;
  for (int tok = blockIdx.x * 4 + wv; tok < TOK; tok += gridDim.x * 4) {
    bf16_t* zr = z + (size_t)tok * NSP;
    const int b = tok >> 11, s = tok & 2047;
    if (lane < 48) zr[NGL + lane] = f2bf(slab_sum(slab, tok, lane) * row_rsc(rowss, tok));
    float c[4], sn[4];
    const int ps = pos[tok];
#pragma unroll
    for (int e = 0; e < 4; ++e) rope_cs(ps, d0 + e, 13.287712379549449f / 64.f, c[e], sn[e]);
    float y1[4], y2[4];
#pragma unroll
    for (int it = 0; it < 4; ++it) {
      bf16_t* p = zr + NQ + (it * 4 + hq) * 128 + d0;
      rope4(p, c, sn, y1, y2); st4bf(p, y1); st4bf(p + 64, y2);
    }
    { bf16_t* p = zr + NKS + hq * 128 + d0; rope4(p, c, sn, y1, y2); st4bf(p, y1); st4bf(p + 64, y2); }
    { bf16_t* p = zr + NKW + hq * 128 + d0; rope4(p, c, sn, y1, y2); st4bf(p, y1); st4bf(p + 64, y2); }
    rope4(zr + NKC + hq * 128 + d0, c, sn, y1, y2);
    float v1[4], v2[4];
    {
      const u32x2 a = *(const u32x2*)(zr + NVC + hq * 128 + d0), bq = *(const u32x2*)(zr + NVC + hq * 128 + 64 + d0);
      v1[0] = lo2f(a[0]); v1[1] = hi2f(a[0]); v1[2] = lo2f(a[1]); v1[3] = hi2f(a[1]);
      v2[0] = lo2f(bq[0]); v2[1] = hi2f(bq[0]); v2[2] = lo2f(bq[1]); v2[3] = hi2f(bq[1]);
    }
    const int n1 = s >> 4, l1 = s & 15;
    const size_t rb = (size_t)(b * 4 + hq) * 128;
#pragma unroll
    for (int w = 0; w < 2; ++w) {
      const int n = n1 - w, l = l1 + 16 * w;
      if (n >= 0 && n <= 126) {
        const size_t o = (rb + n) * 4096 + l * 128 + d0;
        const f32x4 pk1 = *(const f32x4*)(cpos + l * 128 + d0), pk2 = *(const f32x4*)(cpos + l * 128 + 64 + d0);
        const f32x4 pv1 = *(const f32x4*)(cpos + 4096 + l * 128 + d0), pv2 = *(const f32x4*)(cpos + 4096 + l * 128 + 64 + d0);
        const float a1[4] = {y1[0] + pk1[0], y1[1] + pk1[1], y1[2] + pk1[2], y1[3] + pk1[3]};
        const float a2[4] = {y2[0] + pk2[0], y2[1] + pk2[1], y2[2] + pk2[2], y2[3] + pk2[3]};
        const float b1[4] = {v1[0] + pv1[0], v1[1] + pv1[1], v1[2] + pv1[2], v1[3] + pv1[3]};
        const float b2[4] = {v2[0] + pv2[0], v2[1] + pv2[1], v2[2] + pv2[2], v2[3] + pv2[3]};
        st4bf(aflk + o, a1); st4bf(aflk + o + 64, a2);
        st4bf(aflv + o, b1); st4bf(aflv + o + 64, b2);
      }
    }
  }
}

template <int QS>
DI void load_q128(const bf16_t* __restrict__ z, size_t tb, int hh, int q0, int wave, int lane, bf16x8 (&qf)[QS][6], int (&qi)[QS]) {
#pragma unroll
  for (int qs = 0; qs < QS; ++qs) {
    qi[qs] = q0 + wave * (16 * QS) + qs * 16 + (lane & 15);
    const bf16_t* qp = z + (tb + qi[qs]) * NSP + NQ + hh * 128;
#pragma unroll
    for (int ks = 0; ks < 4; ++ks) qf[qs][ks] = *(const bf16x8*)(qp + ks * 32 + (lane >> 4) * 8);
    qf[qs][4] = qf[qs][0]; qf[qs][5] = qf[qs][0];
  }
}
DI float nsa_gate(const bf16_t* __restrict__ z, const float* __restrict__ bg, size_t tokrow, int hh, int c) {
  return sigmoidf_(bf2f(z[tokrow * NSP + NGL + hh * 3 + c]) + bg[hh * 3 + c]);
}

template <int QS>
DI void nsa_cmpwin_item(int item, const bf16_t* __restrict__ z, const bf16_t* __restrict__ kcmp, const bf16_t* __restrict__ vcmp,
                                const float* __restrict__ bgate, float* __restrict__ P, float* __restrict__ part, char* smem) {
  const int tid = tidx(), lane = tid & 63, wave = tid >> 6, g = lane >> 4;
  const int qt = item % NQT, hh = (item / NQT) & 15, b = item / (NQT * 16), grp = hh >> 2;
  const int q0 = qt * QB;
  const size_t tb = (size_t)b * SEQ;
  bf16x8 qf[QS][6]; int qi[QS]; unsigned qm[QS] = {};
  load_q128<QS>(z, tb, hh, q0, wave, lane, qf, qi);
  const float sc = 0.08838834764831845f * 1.4426950408889634f;
  f32x4 o[QS][8];
  {
    __syncthreads();
    const bf16_t* kc = kcmp + (size_t)(b * 4 + grp) * 128 * 128;
    const bf16_t* vc = vcmp + (size_t)(b * 4 + grp) * 128 * 128;
    load_tile_k(tid, kc, 128, smem); load_tile_k(tid, kc + 64 * 128, 128, smem + 16384);
    load_tile_v(tid, vc, 128, smem + 32768); load_tile_v(tid, vc + 64 * 128, 128, smem + 49152);
    __syncthreads();
    f32x4 s0[4][QS], s1[4][QS];
#pragma unroll
    for (int kt = 0; kt < 4; ++kt)
#pragma unroll
      for (int qs = 0; qs < QS; ++qs) { s0[kt][qs] = (f32x4){0.f, 0.f, 0.f, 0.f}; s1[kt][qs] = (f32x4){0.f, 0.f, 0.f, 0.f}; }
    qk_tile<4, QS>(smem, qf, 0, s0, lane);
    qk_tile<4, QS>(smem + 16384, qf, 0, s1, lane);
#pragma unroll
    for (int qs = 0; qs < QS; ++qs) {
      float mx = -1e30f;
#pragma unroll
      for (int kt = 0; kt < 4; ++kt)
#pragma unroll
        for (int r = 0; r < 4; ++r) {
          const int n = kt * 16 + 4 * g + r;
          const float x0 = (16 * n + 31 <= qi[qs]) ? s0[kt][qs][r] * sc : -1e30f;
          const float x1 = (16 * (n + 64) + 31 <= qi[qs]) ? s1[kt][qs][r] * sc : -1e30f;
          s0[kt][qs][r] = x0; s1[kt][qs][r] = x1; mx = fmaxf(mx, fmaxf(x0, x1));
        }
      mx = fmaxf(mx, __shfl_xor(mx, 16)); mx = fmaxf(mx, __shfl_xor(mx, 32));
      float ps = 0.f;
#pragma unroll
      for (int kt = 0; kt < 4; ++kt)
#pragma unroll
        for (int r = 0; r < 4; ++r) {
          const float p0 = s0[kt][qs][r] > -1e29f ? exp2f(s0[kt][qs][r] - mx) : 0.f;
          const float p1 = s1[kt][qs][r] > -1e29f ? exp2f(s1[kt][qs][r] - mx) : 0.f;
          s0[kt][qs][r] = p0; s1[kt][qs][r] = p1; ps += p0 + p1;
        }
      ps += __shfl_xor(ps, 16); ps += __shfl_xor(ps, 32);
      const float inv = ps > 0.f ? 1.f / ps : 0.f;
      float* pp = P + (((size_t)b * 16 + hh) * SEQ + qi[qs]) * 128;
#pragma unroll
      for (int kt = 0; kt < 4; ++kt) {
        s0[kt][qs] *= inv; s1[kt][qs] *= inv;
        *(f32x4*)(pp + kt * 16 + 4 * g) = s0[kt][qs];
        *(f32x4*)(pp + 64 + kt * 16 + 4 * g) = s1[kt][qs];
      }
    }
#pragma unroll
    for (int qs = 0; qs < QS; ++qs)
#pragma unroll
      for (int dt = 0; dt < 8; ++dt) o[qs][dt] = (f32x4){0.f, 0.f, 0.f, 0.f};
    pv_tile<QS>(smem + 32768, s0, o, lane);
    pv_tile<QS>(smem + 49152, s1, o, lane);
#pragma unroll
    for (int qs = 0; qs < QS; ++qs) {
      const float g0 = nsa_gate(z, bgate, tb + qi[qs], hh, 0);
      float* op = part + (tb + qi[qs]) * DM + hh * 128;
#pragma unroll
      for (int dt = 0; dt < 8; ++dt) *(f32x4*)(op + dt * 16 + 4 * g) = o[qs][dt] * g0;
    }
  }
  {
    char* Ks = smem; char* Vs = smem + 16384;
#pragma unroll
    for (int qs = 0; qs < QS; ++qs)
#pragma unroll
      for (int dt = 0; dt < 8; ++dt) o[qs][dt] = (f32x4){0.f, 0.f, 0.f, 0.f};
    float m[QS], l[QS];
#pragma unroll
  for (int qs = 0; qs < QS; ++qs) { m[qs] = -1e30f; l[qs] = 0.f; }
    const int j0 = (qt * QS - 8) > 0 ? (qt * QS - 8) : 0, j1 = qt * QS + QS - 1;
#pragma unroll 1
    for (int j = j0; j <= j1; ++j) {
      __syncthreads();
      load_tile_k(tid, z + (tb + j * 64) * NSP + NKW + grp * 128, NSP, Ks);
      load_tile_v(tid, z + (tb + j * 64) * NSP + NVW + grp * 128, NSP, Vs);
      __syncthreads();
      f32x4 s[4][QS];
#pragma unroll
      for (int kt = 0; kt < 4; ++kt)
#pragma unroll
        for (int qs = 0; qs < QS; ++qs) s[kt][qs] = (f32x4){0.f, 0.f, 0.f, 0.f};
      qk_tile<4, QS>(Ks, qf, 0, s, lane);
      softmax_tile<AM_WIN, QS>(s, o, m, l, qi, qm, j * 64, 0, sc, lane, (j * 64 + 63 <= q0) && (j * 64 > q0 + QB - 1 - 512));
      pv_tile<QS>(Vs, s, o, lane);
    }
#pragma unroll
    for (int qs = 0; qs < QS; ++qs) {
      float lt = l[qs]; lt += __shfl_xor(lt, 16); lt += __shfl_xor(lt, 32);
      const float inv = (lt > 0.f ? 1.f / lt : 0.f) * nsa_gate(z, bgate, tb + qi[qs], hh, 2);
      float* op = part + (tb + qi[qs]) * DM + hh * 128;
#pragma unroll
      for (int dt = 0; dt < 8; ++dt) { f32x4 pv = *(f32x4*)(op + dt * 16 + 4 * g); pv += o[qs][dt] * inv; *(f32x4*)(op + dt * 16 + 4 * g) = pv; }
    }
  }
}

DI void nsa_select(const float* __restrict__ P, unsigned* __restrict__ sel) {
  const int tid = tidx(), lane = tid & 63, wv = tid >> 6, m = lane & 31, half = lane >> 5;
  for (int base = (blockIdx.x * 4 + wv) * 2; base < 16 * SEQ; base += gridDim.x * 8) {
    const int idx = base + half;
    const int bg = idx >> 11, s = idx & 2047, b = bg >> 2, grp = bg & 3;
    float imp = 0.f, lastv = 0.f;
#pragma unroll
    for (int j = 0; j < 4; ++j) {
      const f32x4 pv = *(const f32x4*)(P + (((size_t)b * 16 + grp * 4 + j) * SEQ + s) * 128 + 4 * m);
      imp += (pv[0] + pv[1]) + (pv[2] + pv[3]);
      lastv += pv[3];
    }
    {
      const float prevl = __shfl(lastv, half * 32 + ((m + 31) & 31));
      if (m >= 1) imp += prevl;
    }
    const int cur = s >> 6;
    const bool cand = (m >= 1) && (m <= cur - 2);
    int rank = 0;
    for (int mm = 0; mm < 32; ++mm) {
      const float v = __shfl(imp, half * 32 + mm);
      const bool c2 = (mm >= 1) && (mm <= cur - 2);
      if (c2 && (v > imp || (v == imp && mm < m))) ++rank;
    }
    bool selb;
    if (cur <= 15) selb = (m <= cur);
    else selb = (m == 0) || (m == cur) || (m == cur - 1) || (cand && rank < 13);
    const unsigned long long bal = __ballot(selb);
    const unsigned mk = half ? (unsigned)(bal >> 32) : (unsigned)(bal & 0xffffffffull);
    if (m == 0) sel[idx] = mk;
  }
}

template <int QS>
DI void nsa_sel_item(int item, const bf16_t* __restrict__ z, const unsigned* __restrict__ sel, const float* __restrict__ bgate,
                             const float* __restrict__ part, bf16_t* __restrict__ mix, char* smem) {
  const int tid = tidx(), lane = tid & 63, wave = tid >> 6, g = lane >> 4;
  const int qt = (NQT - 1) - (item >> 6), bh = item & 63, b = bh >> 4, hh = bh & 15, grp = hh >> 2;
  const int q0 = qt * QB;
  const size_t tb = (size_t)b * SEQ;
  bf16x8 qf[QS][6]; int qi[QS]; unsigned qm[QS];
  load_q128<QS>(z, tb, hh, q0, wave, lane, qf, qi);
  unsigned um = 0u;
#pragma unroll
  for (int qs = 0; qs < QS; ++qs) { qm[qs] = sel[(size_t)(b * 4 + grp) * SEQ + qi[qs]]; um |= qm[qs]; }
#pragma unroll
  for (int o2 = 1; o2 < 16; o2 <<= 1) um |= __shfl_xor(um, o2);
  unsigned* ush = (unsigned*)(smem + 40960);
  __syncthreads();
  if (lane == 0) ush[wave] = um;
  __syncthreads();
  um = ush[0] | ush[1] | ush[2] | ush[3];
  const float sc = 0.08838834764831845f * 1.4426950408889634f;
  char* Ks = smem; char* Vs = smem + 16384;
  f32x4 o[QS][8];
#pragma unroll
  for (int qs = 0; qs < QS; ++qs)
#pragma unroll
    for (int dt = 0; dt < 8; ++dt) o[qs][dt] = (f32x4){0.f, 0.f, 0.f, 0.f};
  float m[QS], l[QS];
#pragma unroll
  for (int qs = 0; qs < QS; ++qs) { m[qs] = -1e30f; l[qs] = 0.f; }
  const int j1 = qt * QS + QS - 1;
  unsigned rem = um & ((j1 >= 31) ? 0xffffffffu : ((2u << j1) - 1u));
#pragma unroll 1
  while (rem) {
    const int j = __builtin_ctz(rem);
    rem &= rem - 1u;
    __syncthreads();
    load_tile_k(tid, z + (tb + j * 64) * NSP + NKS + grp * 128, NSP, Ks);
    load_tile_v(tid, z + (tb + j * 64) * NSP + NVS + grp * 128, NSP, Vs);
    __syncthreads();
    f32x4 s[4][QS];
#pragma unroll
    for (int kt = 0; kt < 4; ++kt)
#pragma unroll
      for (int qs = 0; qs < QS; ++qs) s[kt][qs] = (f32x4){0.f, 0.f, 0.f, 0.f};
    qk_tile<4, QS>(Ks, qf, 0, s, lane);
    softmax_tile<AM_SEL, QS>(s, o, m, l, qi, qm, j * 64, j, sc, lane, j * 64 + 63 <= q0);
    pv_tile<QS>(Vs, s, o, lane);
  }
#pragma unroll
  for (int qs = 0; qs < QS; ++qs) {
    float lt = l[qs]; lt += __shfl_xor(lt, 16); lt += __shfl_xor(lt, 32);
    const float inv = (lt > 0.f ? 1.f / lt : 0.f) * nsa_gate(z, bgate, tb + qi[qs], hh, 1);
    const float* pp = part + (tb + qi[qs]) * DM + hh * 128;
    bf16_t* op = mix + (tb + qi[qs]) * DM + hh * 128;
#pragma unroll
    for (int dt = 0; dt < 8; ++dt) {
      const f32x4 pv = *(const f32x4*)(pp + dt * 16 + 4 * g);
      uint2 w; w.x = pack2(pv[0] + o[qs][dt][0] * inv, pv[1] + o[qs][dt][1] * inv); w.y = pack2(pv[2] + o[qs][dt][2] * inv, pv[3] + o[qs][dt][3] * inv);
      *(uint2*)(op + dt * 16 + 4 * g) = w;
    }
  }
}


#define XB_TMO      128
#define XB_XCNT(j)  (256  + 64 * (j))
#define XB_XSUB(j)  (1280 + 64 * (j))
#define XB_XGEN(j)  (2304 + 64 * (j))
#define XB_TOP      3328
#define XB_TOPGEN   3392
#define XCD_BAR_WORDS 3456
#define XB_SPIN_CAP (1u << 20)
#define LAS __attribute__((address_space(3)))
DI unsigned xb_ld(unsigned* p)              { return __hip_atomic_load(p, __ATOMIC_RELAXED, __HIP_MEMORY_SCOPE_AGENT); }
DI unsigned xb_add(unsigned* p, unsigned v) { return __hip_atomic_fetch_add(p, v, __ATOMIC_RELAXED, __HIP_MEMORY_SCOPE_AGENT); }
DI unsigned xb_xcc_id() { return (unsigned)__builtin_amdgcn_s_getreg((3 << 11) | 20) & 0xFu; }
#define XB_SPIN(cond, bar) do { unsigned _sp = 0; while (cond) { __builtin_amdgcn_s_sleep(1); \
    if ((++_sp & 255u) == 0u) { if (xb_ld(&(bar)[XB_TMO])) break; if (_sp > XB_SPIN_CAP) { atomicAdd(&(bar)[XB_TMO], 1u); break; } } } } while (0)
struct XcdBarrier { unsigned* bar; unsigned x; volatile LAS unsigned* st; };
DI XcdBarrier xcd_barrier_post(unsigned* bar, volatile LAS unsigned* st) {
  XcdBarrier b; b.bar = bar; b.x = xb_xcc_id(); b.st = st;
  if (threadIdx.x == 0) (void)xb_add(&bar[XB_XCNT(b.x)], 1u);
  return b;
}
DI void xcd_barrier_complete(unsigned* bar, unsigned x, unsigned& nloc, unsigned& nx) {
  const unsigned G = gridDim.x * gridDim.y * gridDim.z;
  unsigned sum, cnt, mine, sp = 0u;
  for (;;) {
    sum = 0u; cnt = 0u; mine = 0u;
#pragma unroll
    for (unsigned j = 0; j < 16; ++j) { const unsigned c = xb_ld(&bar[XB_XCNT(j)]); sum += c; cnt += (c > 0u) ? 1u : 0u; mine = (j == x) ? c : mine; }
    if (sum == G) break;
    __builtin_amdgcn_s_sleep(1);
    if ((++sp & 255u) == 0u) { if (xb_ld(&bar[XB_TMO])) break; if (sp > XB_SPIN_CAP) { atomicAdd(&bar[XB_TMO], 1u); break; } }
  }
  nloc = mine > 0u ? mine : 1u; nx = cnt > 0u ? cnt : 1u;
}
DI void xcd_barrier(const XcdBarrier& b) {
  asm volatile("s_waitcnt vmcnt(0)" ::: "memory");
  __syncthreads();
  if (threadIdx.x == 0) {
    unsigned* bar = b.bar;
    __builtin_amdgcn_s_waitcnt(0);
    unsigned nloc = b.st[0], nx = b.st[1];
    if (nloc == 0u) { xcd_barrier_complete(bar, b.x, nloc, nx); b.st[0] = nloc; b.st[1] = nx; }
    const unsigned old = xb_add(&bar[XB_XSUB(b.x)], 1u);
    const unsigned gen = old / nloc;
    if (old + 1u == (gen + 1u) * nloc) {
      __builtin_amdgcn_fence(__ATOMIC_RELEASE, "agent");
      asm volatile("s_waitcnt vmcnt(0)" ::: "memory");
      const unsigned og = xb_add(&bar[XB_TOP], 1u);
      const unsigned tg = og / nx;
      if (og + 1u == (tg + 1u) * nx) xb_add(&bar[XB_TOPGEN], 1u);
      else XB_SPIN(xb_ld(&bar[XB_TOPGEN]) == tg, bar);
      __builtin_amdgcn_fence(__ATOMIC_ACQUIRE, "agent");
      xb_add(&bar[XB_XGEN(b.x)], 1u);
      asm volatile("s_waitcnt vmcnt(0)" ::: "memory");
    } else {
      XB_SPIN(xb_ld(&bar[XB_XGEN(b.x)]) == gen, bar);
      __builtin_amdgcn_fence(__ATOMIC_ACQUIRE, "agent");
      asm volatile("s_waitcnt vmcnt(0)" ::: "memory");
    }
  }
  __syncthreads();
}

DI void flat_barrier(unsigned* cnt, unsigned target) {
  asm volatile("s_waitcnt vmcnt(0)" ::: "memory");
  __syncthreads();
  if (threadIdx.x == 0) {
    __builtin_amdgcn_fence(__ATOMIC_RELEASE, "agent");
    asm volatile("s_waitcnt vmcnt(0)" ::: "memory");
    (void)xb_add(cnt, 1u);
    unsigned sp = 0u;
    while (xb_ld(cnt) < target) { __builtin_amdgcn_s_sleep(1); if (++sp > (1u << 24)) break; }
    __builtin_amdgcn_fence(__ATOMIC_ACQUIRE, "agent");
    asm volatile("s_waitcnt vmcnt(0)" ::: "memory");
  }
  __syncthreads();
}

DI void hier_barrier(unsigned* bar, volatile LAS unsigned* st) {
  asm volatile("s_waitcnt vmcnt(0)" ::: "memory");
  __syncthreads();
  if (threadIdx.x == 0) {
    const unsigned x = blockIdx.x & 7u;
    __builtin_amdgcn_fence(__ATOMIC_RELEASE, "agent");
    asm volatile("s_waitcnt vmcnt(0)" ::: "memory");
    unsigned nloc = st[0], nx = st[1];
    if (nloc == 0u) { xcd_barrier_complete(bar, x, nloc, nx); st[0] = nloc; st[1] = nx; }
    const unsigned old = xb_add(&bar[XB_XSUB(x)], 1u);
    const unsigned gen = old / nloc;
    if (old + 1u == (gen + 1u) * nloc) {
      const unsigned og = xb_add(&bar[XB_TOP], 1u);
      const unsigned tg = og / nx;
      if (og + 1u == (tg + 1u) * nx) xb_add(&bar[XB_TOPGEN], 1u);
      else XB_SPIN(xb_ld(&bar[XB_TOPGEN]) == tg, bar);
      xb_add(&bar[XB_XGEN(x)], 1u);
    } else {
      XB_SPIN(xb_ld(&bar[XB_XGEN(x)]) == gen, bar);
    }
    __builtin_amdgcn_fence(__ATOMIC_ACQUIRE, "agent");
    asm volatile("s_waitcnt vmcnt(0)" ::: "memory");
  }
  __syncthreads();
}

__global__ void __launch_bounds__(256, 2) mega(Params p) {
  cg::grid_group grid = cg::this_grid();
  __shared__ __attribute__((aligned(16))) char smem[65536 + 16];
  char* ws = p.ws;
  if (threadIdx.x == 0) { *(unsigned*)(smem + 65536) = 0u; *(unsigned*)(smem + 65540) = 0u; }
  __syncthreads();
  const XcdBarrier xb = xcd_barrier_post((unsigned*)(ws + A_BAR), (volatile LAS unsigned*)LDSP(unsigned, smem + 65536));
  if (p.out == nullptr) grid.sync();
  const int* pos = (const int*)p.in[2];
  float* h = (float*)(ws + A_H);
  bf16_t* hn = (bf16_t*)(ws + A_HN);
  bf16_t* mix = (bf16_t*)(ws + A_MIX);
  float* mb = (float*)(ws + A_MB);
  float* rss = (float*)(ws + A_RSS);
  bf16_t* mbh = (bf16_t*)(ws + A_MB) + (size_t)TOK * DM;
  bf16_t* zb = (bf16_t*)(ws + A_R1);
  bf16_t* hid = (bf16_t*)(ws + A_R1);

  for (int j = 0; j < 2; ++j) {
    transpose_job(p.in[7] + (size_t)j * 2048 * ABN, 2048, ABN, ABP, (bf16_t*)(ws + W_ABIN) + (size_t)j * ABP * 2048, 0, smem);
    transpose_job(p.in[12] + (size_t)j * 512 * 1536, 512, 1536, 1536, (bf16_t*)(ws + W_UQ) + (size_t)j * 1536 * 512, 0, smem);
    transpose_job(p.in[14] + (size_t)j * 512 * 2048, 512, 2048, 2048, (bf16_t*)(ws + W_UKV) + (size_t)j * 2048 * 512, 0, smem);
    transpose_job(p.in[15] + (size_t)j * 2048 * 2048, 2048, 2048, 2048, (bf16_t*)(ws + W_ABOUT) + (size_t)j * 2048 * 2048, 0, smem);
    transpose_job(p.in[16] + (size_t)j * 2048 * NSN, 2048, NSN, NSP, (bf16_t*)(ws + W_NSIN) + (size_t)j * NSP * 2048, 0, smem);
    for (int kv = 0; kv < 2; ++kv) {
      transpose_job(p.in[19] + (size_t)(j * 2 + kv) * 4096 * 128, 4096, 128, 128, (bf16_t*)(ws + W_W1) + (size_t)(j * 2 + kv) * 128 * 4096, 0, smem);
      transpose_job(p.in[20] + (size_t)(j * 2 + kv) * 128 * 128, 128, 128, 128, (bf16_t*)(ws + W_W2) + (size_t)(j * 2 + kv) * 128 * 128, 0, smem);
    }
    transpose_job(p.in[21] + (size_t)j * 2048 * 2048, 2048, 2048, 2048, (bf16_t*)(ws + W_NSOUT) + (size_t)j * 2048 * 2048, 0, smem);
  }
  for (int i = 0; i < 4; ++i) {
    transpose_job(p.in[22] + (size_t)i * 2048 * FH, 2048, FH, FH, (bf16_t*)(ws + W_FGU) + (size_t)i * 11264 * 2048, 1, smem);
    transpose_job(p.in[23] + (size_t)i * 2048 * FH, 2048, FH, FH, (bf16_t*)(ws + W_FGU) + (size_t)i * 11264 * 2048, 2, smem);
    transpose_job(p.in[24] + (size_t)i * FH * 2048, FH, 2048, 2048, (bf16_t*)(ws + W_FD) + (size_t)i * 2048 * FH, 0, smem);
    transpose_job(p.in[25] + (size_t)i * 2048 * 2048, 2048, 2048, 2048, (bf16_t*)(ws + W_PG) + (size_t)i * 2048 * 2048, 0, smem);
    transpose_job(p.in[27] + (size_t)i * 256 * 2048, 256, 2048, 2048, (bf16_t*)(ws + W_PP) + (size_t)i * 2048 * 256, 0, smem);
  }
  {
    const float* pp = p.in[1]; bf16_t* pb = (bf16_t*)(ws + A_PBF);
    for (size_t i = (size_t)blockIdx.x * 256 + tidx(); i < (size_t)4 * TOK * 256 / 4; i += (size_t)gridDim.x * 256) {
      const f32x4 t4 = __builtin_nontemporal_load((const f32x4*)(pp + i * 4)); const float4 v = make_float4(t4[0], t4[1], t4[2], t4[3]);
      uint2 o; o.x = pack2(v.x, v.y); o.y = pack2(v.z, v.w);
      *(uint2*)(pb + i * 4) = o;
    }
  }
  row_pass(p.in[0], nullptr, nullptr, h, p.in[3], hn);
  xcd_barrier(xb);
  unsigned bepoch = 0u;

  for (int layer = 0; layer < 4; ++layer) {
    const int j = layer >> 1;
    GArgs ga{};
    if ((layer & 1) == 0) {
      ga = GArgs{}; ga.A = (layer == 0) ? hn : mix; ga.rowss = (layer == 0) ? nullptr : rss; ga.lda = DM; ga.Bt = (bf16_t*)(ws + W_ABIN) + (size_t)j * ABP * 2048; ga.K = 2048; ga.M = TOK; ga.Npad = 4096; ga.C = zb; ga.ldc = ABP;
      gemm_phase<EPI_BF16>(ga, smem);
      gemm_tail_splitk(ga.A, ga.Bt + (size_t)4096 * 2048, (float*)(ws + A_R3), smem);
      xcd_barrier(xb);
      bf16_t* cqn = (bf16_t*)(ws + A_R5); bf16_t* ckvn = cqn + (size_t)TOK * 512; bf16_t* krope = (bf16_t*)(ws + A_KR);
      float* ogla = (float*)(ws + A_R4);
      bf16_t* mq = (bf16_t*)(ws + A_R3); bf16_t* mkv = mq + (size_t)TOK * 1536;
      float* Ubuf = mb; float* Ebuf = mb + (size_t)10 * 1024 * 1024;
      for (int it = blockIdx.x; it < 1024; it += gridDim.x) gla_pass1(it, zb, p.in[8] + (size_t)j * 16 * 512, p.in[9] + (size_t)j * 512, Ubuf, Ebuf, smem);
      mla_prep(blockIdx.x, gridDim.x, zb, p.in[11] + j * 512, p.in[13] + j * 512, pos, cqn, ckvn, krope, (const float*)(ws + A_R3), (layer == 0) ? nullptr : rss);
      xcd_barrier(xb);
      gla_pass2(Ubuf, Ebuf);
      ga = GArgs{}; ga.A = cqn; ga.lda = 512; ga.Bt = (bf16_t*)(ws + W_UQ) + (size_t)j * 1536 * 512; ga.K = 512; ga.M = TOK; ga.Npad = 1536; ga.C = mq; ga.ldc = 1536;
      gemm_phase<EPI_BF16>(ga, smem);
      ga = GArgs{}; ga.A = ckvn; ga.lda = 512; ga.Bt = (bf16_t*)(ws + W_UKV) + (size_t)j * 2048 * 512; ga.K = 512; ga.M = TOK; ga.Npad = 2048; ga.C = mkv; ga.ldc = 2048;
      gemm_phase<EPI_BF16>(ga, smem);
      xcd_barrier(xb);
      for (int it = blockIdx.x; it < 1024; it += gridDim.x) gla_pass3(it, zb, p.in[8] + (size_t)j * 16 * 512, p.in[9] + (size_t)j * 512, Ubuf, p.in[10] + j * 128, mix, smem);
      {
        int r = 0;
        for (int base = 0; base < 32 * (SEQ / (64 * QS_MLA)); base += gridDim.x, ++r) {
          const int it = base + ((r & 1) ? (gridDim.x - 1 - blockIdx.x) : blockIdx.x);
          if (it < 32 * (SEQ / (64 * QS_MLA))) mla_attn_item<QS_MLA>(it, mq, mkv, krope, pos, mix, smem);
        }
      }
      xcd_barrier(xb);
      ga = GArgs{}; ga.A = mix; ga.lda = DM; ga.Bt = (bf16_t*)(ws + W_ABOUT) + (size_t)j * 2048 * 2048; ga.K = 2048; ga.M = TOK; ga.Npad = 2048; ga.C = mbh; ga.ldc = DM;
      gemm_phase<EPI_BF16>(ga, smem);
      xcd_barrier(xb);
    } else {
      ga = GArgs{}; ga.A = mix; ga.rowss = rss; ga.lda = DM; ga.Bt = (bf16_t*)(ws + W_NSIN) + (size_t)j * NSP * 2048; ga.K = 2048; ga.M = TOK; ga.Npad = 5120; ga.C = zb; ga.ldc = NSP;
      gemm_phase<EPI_BF16>(ga, smem);
      gemm_tail_splitk(ga.A, ga.Bt + (size_t)5120 * 2048, (float*)(ws + A_R3), smem);
      xcd_barrier(xb);
      bf16_t* aflk = (bf16_t*)(ws + A_R4); bf16_t* aflv = aflk + (size_t)2048 * 4096;
      bf16_t* hck = (bf16_t*)(ws + A_R5); bf16_t* hcv = hck + 2048 * 128; bf16_t* kcmp = hcv + 2048 * 128; bf16_t* vcmp = kcmp + 2048 * 128;
      float* P = (float*)(ws + A_R3);
      unsigned* sel = (unsigned*)(ws + A_SEL);
      const float* bgate = p.in[17] + j * 48;
      nsa_prep(zb, pos, p.in[18] + (size_t)j * 2 * 4096, aflk, aflv, (const float*)(ws + A_R3), rss);
      xcd_barrier(xb);
      ga = GArgs{}; ga.A = aflk; ga.lda = 4096; ga.Bt = (bf16_t*)(ws + W_W1) + (size_t)(j * 2) * 128 * 4096; ga.K = 4096; ga.M = 2048; ga.Npad = 128; ga.C = hck; ga.ldc = 128;
      gemm_phase<EPI_GELU>(ga, smem);
      ga.A = aflv; ga.Bt = (bf16_t*)(ws + W_W1) + (size_t)(j * 2 + 1) * 128 * 4096; ga.C = hcv;
      gemm_phase<EPI_GELU>(ga, smem);
      xcd_barrier(xb);
      ga = GArgs{}; ga.A = hck; ga.lda = 128; ga.Bt = (bf16_t*)(ws + W_W2) + (size_t)(j * 2) * 128 * 128; ga.K = 128; ga.M = 2048; ga.Npad = 128; ga.C = kcmp; ga.ldc = 128;
      gemm_phase<EPI_BF16>(ga, smem);
      ga.A = hcv; ga.Bt = (bf16_t*)(ws + W_W2) + (size_t)(j * 2 + 1) * 128 * 128; ga.C = vcmp;
      gemm_phase<EPI_BF16>(ga, smem);
      xcd_barrier(xb);
      for (int it = blockIdx.x; it < 64 * (SEQ / (64 * QS_CW)); it += gridDim.x) nsa_cmpwin_item<QS_CW>(it, zb, kcmp, vcmp, bgate, P, mb, smem);
      xcd_barrier(xb);
      nsa_select(P, sel);
      xcd_barrier(xb);
      {
        int r = 0;
        for (int base = 0; base < 64 * (SEQ / (64 * QS_SEL)); base += gridDim.x, ++r) {
          const int it = base + ((r & 1) ? (gridDim.x - 1 - blockIdx.x) : blockIdx.x);
          if (it < 64 * (SEQ / (64 * QS_SEL))) nsa_sel_item<QS_SEL>(it, zb, sel, bgate, mb, mix, smem);
        }
      }
      xcd_barrier(xb);
      ga = GArgs{}; ga.A = mix; ga.lda = DM; ga.Bt = (bf16_t*)(ws + W_NSOUT) + (size_t)j * 2048 * 2048; ga.K = 2048; ga.M = TOK; ga.Npad = 2048; ga.C = mbh; ga.ldc = DM;
      gemm_phase<EPI_BF16>(ga, smem);
      xcd_barrier(xb);
    }
    row_pass(nullptr, mbh, p.in[4] + layer * DM, h, p.in[5] + layer * DM, hn);
    xcd_barrier(xb);
    ga = GArgs{}; ga.A = hn; ga.lda = DM; ga.Bt = (bf16_t*)(ws + W_FGU) + (size_t)layer * 11264 * 2048; ga.K = 2048; ga.M = TOK; ga.Npad = 11264; ga.C = hid; ga.ldc = FH;
    gemm_phase<EPI_SWIGLU>(ga, smem);
    xcd_barrier(xb);
    ga = GArgs{}; ga.A = hid; ga.lda = FH; ga.Bt = (bf16_t*)(ws + W_FD) + (size_t)layer * 2048 * FH; ga.K = FH; ga.M = TOK; ga.Npad = 2048; ga.C = mbh; ga.ldc = DM;
    gemm_phase<EPI_BF16>(ga, smem);
    xcd_barrier(xb);
    row_pass(nullptr, mbh, p.in[6] + layer * DM, h, nullptr, hn);
    xcd_barrier(xb);
    ga = GArgs{}; ga.A = hn; ga.lda = DM; ga.Bt = (bf16_t*)(ws + W_PG) + (size_t)layer * 2048 * 2048; ga.K = 2048; ga.M = TOK; ga.Npad = 2048;
    ga.A2 = (bf16_t*)(ws + A_PBF) + (size_t)layer * TOK * 256; ga.lda2 = 256; ga.Bt2 = (bf16_t*)(ws + W_PP) + (size_t)layer * 2048 * 256; ga.K2 = 256;
    ga.bias = p.in[26] + layer * DM; ga.hsrc = h; ga.C = (layer == 3) ? p.out : h; ga.ldc = DM;
    if (layer < 3) { ga.wnext = p.in[3] + (layer + 1) * DM; ga.hnext = mix; ga.rss = rss; }
    gemm_phase<EPI_PLE>(ga, smem);
    if (layer < 3) xcd_barrier(xb);
  }
}

extern "C" void kernel_launch(void* const* d_in, const int* in_sizes, int n_in, void* d_out, int out_size,
                              void* d_ws, size_t ws_size, hipStream_t stream) {
  static int grid_blocks = 0;
  if (!grid_blocks) {
    int dev = 0, cus = 0, per_cu = 0;
    (void)hipGetDevice(&dev);
    (void)hipDeviceGetAttribute(&cus, hipDeviceAttributeMultiprocessorCount, dev);
    (void)hipOccupancyMaxActiveBlocksPerMultiprocessor(&per_cu, mega, 256, 0);
    if (per_cu > 2) per_cu = 2;
    if (per_cu < 1) per_cu = 1;
    grid_blocks = cus * per_cu;
  }
  if (ws_size < WS_NEED) { fprintf(stderr, "workspace too small: %zu < %zu\n", ws_size, (size_t)WS_NEED); return; }
  Params p{};
  for (int i = 0; i < 28; ++i) p.in[i] = (const float*)d_in[i];
  p.out = (float*)d_out; p.ws = (char*)d_ws;
  void* args[] = {&p};
  (void)hipMemsetAsync((char*)d_ws + A_BAR, 0, 4096 * 4, stream);
  hipError_t e = hipLaunchCooperativeKernel((void*)mega, dim3(grid_blocks), dim3(256), args, 0, stream);
  if (e != hipSuccess) fprintf(stderr, "coop launch failed: %s (grid %d)\n", hipGetErrorString(e), grid_blocks);
}
```
